# Optimizing an MI355X kernel written in HIP

```python
import math
import jax
import jax.numpy as jnp
from jax import lax
import numpy as np

D_MODEL = 1024
BATCH = 16
SEQ = 4096
DEPTH = 4

EPS = 1e-6
S5_WIDTH = D_MODEL
S5_GROUP = 16
S5_GROUPS = S5_WIDTH // S5_GROUP
S5_STATE = 64
S5_CHUNK = 128
M_WIDTH = D_MODEL
M_HEADS = 4
M_HEAD_DIM = M_WIDTH // M_HEADS
M_CONV = 4
M_CHUNK = 128
A_HEAD_DIM = 64
A_HEADS = D_MODEL // A_HEAD_DIM
A_KV_HEADS = A_HEADS // 4
A_WINDOW = 128
ROPE_THETA = 500000.0
ROPE_DIM = A_HEAD_DIM // 4
EVEN_IN = 2 * S5_WIDTH + 2 * M_WIDTH
EVEN_OUT = S5_WIDTH + M_WIDTH
A_Q = A_HEADS * A_HEAD_DIM
A_KV = A_KV_HEADS * A_HEAD_DIM
ODD_IN = 2 * A_Q + 2 * A_KV
N_EVEN = (DEPTH + 1) // 2
N_ODD = DEPTH // 2

kernel_name = 'hybrid_s5_mlstm_swa_trunk'

F32 = jnp.float32


def rmsnorm(x, g):
    xf = x.astype(F32)
    return xf * lax.rsqrt(jnp.mean(xf * xf, axis=-1, keepdims=True) + EPS) * g.astype(F32)


def adaln(c, w, b):
    m = jax.nn.silu(c.astype(F32)) @ w.astype(F32) + b.astype(F32)
    shift, scale, gate = jnp.split(m[:, None, :], 3, axis=-1)
    return shift, scale, gate


def _lin_rec(e1, e2):
    a1, b1 = e1
    a2, b2 = e2
    return a1 * a2, a2 * b1 + b2


def s5_mixer(u, a_re, a_im, log_dt, b_re, b_im, c_re, c_im, d_skip, w_glu):
    bsz, seq, _ = u.shape
    n_chunks = seq // S5_CHUNK
    a = lax.complex(a_re.astype(F32), a_im.astype(F32))
    dt = jnp.exp(log_dt.astype(F32))[:, None]
    a_bar = jnp.exp(a * dt)
    b_bar = ((a_bar - 1.0) / a)[..., None] * lax.complex(b_re.astype(F32), b_im.astype(F32))
    c_mat = lax.complex(c_re.astype(F32), c_im.astype(F32))
    u_chunks = jnp.moveaxis(u.reshape(bsz, n_chunks, S5_CHUNK, S5_GROUPS, S5_GROUP), 1, 0)

    def chunk_step(state, u_c):
        bu = jnp.einsum('btgp,gnp->btgn', u_c.astype(jnp.complex64), b_bar)
        a_cum, xs = lax.associative_scan(_lin_rec, (jnp.broadcast_to(a_bar, bu.shape), bu), axis=1)
        xs = xs + a_cum * state[:, None]
        y = jnp.einsum('btgn,gpn->btgp', xs, c_mat).real
        return xs[:, -1], y

    state0 = jnp.zeros((bsz, S5_GROUPS, S5_STATE), jnp.complex64)
    _, y = lax.scan(chunk_step, state0, u_chunks)
    y = jnp.moveaxis(y, 0, 1).reshape(bsz, seq, S5_WIDTH)
    y = jax.nn.gelu(y + d_skip.astype(F32) * u)
    return y * jax.nn.sigmoid(y @ w_glu.astype(F32))


def causal_conv(x, w, b):
    seq = x.shape[1]
    k_taps = w.shape[0]
    xp = jnp.pad(x, ((0, 0), (k_taps - 1, 0), (0, 0)))
    out = xp[:, 0:seq] * w[0]
    for t in range(1, k_taps):
        out = out + xp[:, t:t + seq] * w[t]
    return out + b


def mlstm_cell(q, k, v, log_i, log_f):
    bsz, nh, seq, dh = q.shape
    n_chunks = seq // M_CHUNK
    chunk = lambda t: jnp.moveaxis(t.reshape(bsz, nh, n_chunks, M_CHUNK, *t.shape[3:]), 2, 0)
    tri = jnp.tril(jnp.ones((M_CHUNK, M_CHUNK), dtype=bool))

    def step(carry, inp):
        c_st, n_st, m_st = carry
        qc, kc, vc, li, lf = inp
        b = jnp.cumsum(lf, axis=-1)
        d_log = b[..., :, None] - b[..., None, :] + li[..., None, :]
        d_log = jnp.where(tri, d_log, -jnp.inf)
        inter = b + m_st[..., None]
        m_t = jnp.maximum(inter, jnp.max(d_log, axis=-1))
        s = jnp.einsum('bhtd,bhsd->bhts', qc, kc) * jnp.exp(d_log - m_t[..., None])
        g = jnp.exp(inter - m_t)
        num = jnp.einsum('bhts,bhsd->bhtd', s, vc) + g[..., None] * jnp.einsum('bhtd,bhde->bhte', qc, c_st)
        den = jnp.sum(s, axis=-1) + g * jnp.einsum('bhtd,bhd->bht', qc, n_st)
        h = num / jnp.maximum(jnp.abs(den), jnp.exp(-m_t))[..., None]
        b_last = b[..., -1]
        w_log = b_last[..., None] - b + li
        m_new = jnp.maximum(b_last + m_st, jnp.max(w_log, axis=-1))
        w_k = jnp.exp(w_log - m_new[..., None])
        decay = jnp.exp(b_last + m_st - m_new)
        c_new = decay[..., None, None] * c_st + jnp.einsum('bhs,bhsd,bhse->bhde', w_k, kc, vc)
        n_new = decay[..., None] * n_st + jnp.einsum('bhs,bhsd->bhd', w_k, kc)
        return (c_new, n_new, m_new), h

    carry0 = (jnp.zeros((bsz, nh, dh, dh), F32), jnp.zeros((bsz, nh, dh), F32), jnp.zeros((bsz, nh), F32))
    _, h = lax.scan(step, carry0, (chunk(q), chunk(k), chunk(v), chunk(log_i), chunk(log_f)))
    return jnp.moveaxis(h, 0, 2).reshape(bsz, nh, seq, dh)


def mlstm_mixer(m_in, conv_w, conv_b, wq, wk, wv, wo, w_if, b_if, norm_g, skip):
    bsz, seq, _ = m_in.shape
    xc = jax.nn.silu(causal_conv(m_in, conv_w.astype(F32), conv_b.astype(F32)))
    heads = lambda t: t.reshape(bsz, seq, M_HEADS, M_HEAD_DIM)
    q = jnp.einsum('blhd,hde->bhle', heads(xc), wq.astype(F32))
    k = jnp.einsum('blhd,hde->bhle', heads(xc), wk.astype(F32)) * (M_HEAD_DIM ** -0.5)
    v = jnp.einsum('blhd,hde->bhle', heads(m_in), wv.astype(F32))
    o = jax.nn.sigmoid(jnp.einsum('blhd,hde->blhe', heads(m_in), wo.astype(F32)))
    gates = jnp.concatenate([xc, m_in], axis=-1) @ w_if.astype(F32) + b_if.astype(F32)
    gates = jnp.moveaxis(gates, -1, 1)
    log_i = gates[:, :M_HEADS]
    log_f = jax.nn.log_sigmoid(gates[:, M_HEADS:])
    h = jnp.moveaxis(mlstm_cell(q, k, v, log_i, log_f), 1, 2)
    h = rmsnorm(o * h, norm_g) + skip.astype(F32).reshape(M_HEADS, M_HEAD_DIM) * heads(xc)
    return h.reshape(bsz, seq, M_WIDTH)


def s5_mlstm_layer(hn, w_in, a_re, a_im, log_dt, b_re, b_im, c_re, c_im, d_skip, w_glu,
                   conv_w, conv_b, wq, wk, wv, wo, w_if, b_if, m_norm_g, m_skip, w_out):
    proj = hn @ w_in.astype(F32)
    s5_u, s5_z, m_in, m_z = jnp.split(proj, [S5_WIDTH, 2 * S5_WIDTH, 2 * S5_WIDTH + M_WIDTH], axis=-1)
    y_s5 = s5_mixer(s5_u, a_re, a_im, log_dt, b_re, b_im, c_re, c_im, d_skip, w_glu) * jax.nn.silu(s5_z)
    y_m = mlstm_mixer(m_in, conv_w, conv_b, wq, wk, wv, wo, w_if, b_if, m_norm_g, m_skip) * jax.nn.silu(m_z)
    return jnp.concatenate([y_s5, y_m], axis=-1) @ w_out.astype(F32)


def rope_partial(x, positions):
    half = ROPE_DIM // 2
    inv_freq = jnp.exp(-math.log(ROPE_THETA) * jnp.arange(half, dtype=F32) / half)
    ang = positions.astype(F32)[..., None] * inv_freq
    cos = jnp.cos(ang)[:, :, None, :]
    sin = jnp.sin(ang)[:, :, None, :]
    x1 = x[..., :half]
    x2 = x[..., half:ROPE_DIM]
    return jnp.concatenate([x1 * cos - x2 * sin, x2 * cos + x1 * sin, x[..., ROPE_DIM:]], axis=-1)


def sliding_window_attention(q, k, v, sinks):
    bsz, seq, _, hd = q.shape
    grp = A_HEADS // A_KV_HEADS
    n_blocks = seq // A_WINDOW
    qb = q.reshape(bsz, n_blocks, A_WINDOW, A_KV_HEADS, grp, hd)
    kp = jnp.pad(k, ((0, 0), (A_WINDOW, 0), (0, 0), (0, 0)))
    vp = jnp.pad(v, ((0, 0), (A_WINDOW, 0), (0, 0), (0, 0)))
    qi = jnp.arange(A_WINDOW)[:, None] + A_WINDOW
    ki = jnp.arange(2 * A_WINDOW)[None, :]
    rel = qi - ki
    band = (rel >= 0) & (rel < A_WINDOW)
    sink_logits = sinks.astype(F32).reshape(A_KV_HEADS, grp)[None, :, :, None, None]
    scale = hd ** -0.5

    def block(j):
        qj = lax.dynamic_index_in_dim(qb, j, axis=1, keepdims=False)
        kj = lax.dynamic_slice_in_dim(kp, j * A_WINDOW, 2 * A_WINDOW, axis=1)
        vj = lax.dynamic_slice_in_dim(vp, j * A_WINDOW, 2 * A_WINDOW, axis=1)
        s = jnp.einsum('bqkgd,bskd->bkgqs', qj, kj) * scale
        valid = band & (ki + j * A_WINDOW - A_WINDOW >= 0)
        s = jnp.where(valid, s, -jnp.inf)
        sink = jnp.broadcast_to(sink_logits, s.shape[:-1] + (1,))
        p = jax.nn.softmax(jnp.concatenate([s, sink], axis=-1), axis=-1)[..., :-1]
        return jnp.einsum('bkgqs,bskd->bqkgd', p, vj)

    out = lax.map(block, jnp.arange(n_blocks))
    return jnp.moveaxis(out, 0, 1).reshape(bsz, seq, A_Q)


def swa_layer(hn, positions, w_in, q_g, k_g, sinks, w_out):
    bsz, seq, _ = hn.shape
    proj = hn @ w_in.astype(F32)
    q, k, v, z = jnp.split(proj, [A_Q, A_Q + A_KV, A_Q + 2 * A_KV], axis=-1)
    q = rope_partial(rmsnorm(q.reshape(bsz, seq, A_HEADS, A_HEAD_DIM), q_g), positions)
    k = rope_partial(rmsnorm(k.reshape(bsz, seq, A_KV_HEADS, A_HEAD_DIM), k_g), positions)
    v = v.reshape(bsz, seq, A_KV_HEADS, A_HEAD_DIM)
    a = sliding_window_attention(q, k, v, sinks)
    return (a * jax.nn.silu(z)) @ w_out.astype(F32)


def setup_inputs(seed: int = 0) -> dict:
    key = jax.random.key(seed)
    ks = iter(jax.random.split(key, 64))

    def nrm(shape, scale):
        return jax.random.normal(next(ks), shape, F32) * scale

    ne, no = N_EVEN, N_ODD
    g, n, p = S5_GROUPS, S5_STATE, S5_GROUP
    x = nrm((BATCH, SEQ, D_MODEL), 1.0)
    c = nrm((BATCH, D_MODEL), 1.0)
    positions = jnp.arange(SEQ, dtype=jnp.int32)[None, :] + jax.random.randint(next(ks), (BATCH, 1), 0, 1024, dtype=jnp.int32)
    ada_w = nrm((DEPTH, D_MODEL, 3 * D_MODEL), 0.5 * D_MODEL ** -0.5)
    ada_b = nrm((DEPTH, 3 * D_MODEL), 0.02)
    norm_g = 1.0 + nrm((DEPTH, D_MODEL), 0.02)
    ev_w_in = nrm((ne, D_MODEL, EVEN_IN), D_MODEL ** -0.5)
    s5_a_re = -0.5 * jnp.exp(nrm((ne, g, n), 0.05))
    s5_a_im = math.pi * jnp.arange(n, dtype=F32) + nrm((ne, g, n), 0.01)
    s5_log_dt = jax.random.uniform(next(ks), (ne, g), F32, math.log(1e-3), math.log(1e-1))
    s5_b_re = nrm((ne, g, n, p), (2 * p) ** -0.5)
    s5_b_im = nrm((ne, g, n, p), (2 * p) ** -0.5)
    s5_c_re = nrm((ne, g, p, n), (2 * n) ** -0.5)
    s5_c_im = nrm((ne, g, p, n), (2 * n) ** -0.5)
    s5_d = nrm((ne, S5_WIDTH), 1.0)
    s5_w_glu = nrm((ne, S5_WIDTH, S5_WIDTH), S5_WIDTH ** -0.5)
    m_conv_w = nrm((ne, M_CONV, M_WIDTH), M_CONV ** -0.5)
    m_conv_b = nrm((ne, M_WIDTH), 0.02)
    m_wq = nrm((ne, M_HEADS, M_HEAD_DIM, M_HEAD_DIM), M_HEAD_DIM ** -0.5)
    m_wk = nrm((ne, M_HEADS, M_HEAD_DIM, M_HEAD_DIM), M_HEAD_DIM ** -0.5)
    m_wv = nrm((ne, M_HEADS, M_HEAD_DIM, M_HEAD_DIM), M_HEAD_DIM ** -0.5)
    m_wo = nrm((ne, M_HEADS, M_HEAD_DIM, M_HEAD_DIM), M_HEAD_DIM ** -0.5)
    m_w_if = nrm((ne, 2 * M_WIDTH, 2 * M_HEADS), 0.1 * (2 * M_WIDTH) ** -0.5)
    m_b_if = jnp.concatenate([nrm((ne, M_HEADS), 0.1), jnp.linspace(3.0, 6.0, M_HEADS, dtype=F32) + nrm((ne, M_HEADS), 0.01)], axis=-1)
    m_norm_g = 1.0 + nrm((ne, M_HEADS, M_HEAD_DIM), 0.02)
    m_skip = 1.0 + nrm((ne, M_WIDTH), 0.02)
    ev_w_out = nrm((ne, EVEN_OUT, D_MODEL), EVEN_OUT ** -0.5)
    od_w_in = nrm((no, D_MODEL, ODD_IN), D_MODEL ** -0.5)
    od_q_norm_g = 1.0 + nrm((no, A_HEAD_DIM), 0.02)
    od_k_norm_g = 1.0 + nrm((no, A_HEAD_DIM), 0.02)
    od_sinks = nrm((no, A_HEADS), 1.0)
    od_w_out = nrm((no, A_Q, D_MODEL), A_Q ** -0.5)
    return {'x': x, 'c': c, 'positions': positions, 'ada_w': ada_w, 'ada_b': ada_b, 'norm_g': norm_g,
            'ev_w_in': ev_w_in, 's5_a_re': s5_a_re, 's5_a_im': s5_a_im, 's5_log_dt': s5_log_dt,
            's5_b_re': s5_b_re, 's5_b_im': s5_b_im, 's5_c_re': s5_c_re, 's5_c_im': s5_c_im,
            's5_d': s5_d, 's5_w_glu': s5_w_glu, 'm_conv_w': m_conv_w, 'm_conv_b': m_conv_b,
            'm_wq': m_wq, 'm_wk': m_wk, 'm_wv': m_wv, 'm_wo': m_wo, 'm_w_if': m_w_if, 'm_b_if': m_b_if,
            'm_norm_g': m_norm_g, 'm_skip': m_skip, 'ev_w_out': ev_w_out, 'od_w_in': od_w_in,
            'od_q_norm_g': od_q_norm_g, 'od_k_norm_g': od_k_norm_g, 'od_sinks': od_sinks, 'od_w_out': od_w_out}


def reference(x, c, positions, ada_w, ada_b, norm_g, ev_w_in, s5_a_re, s5_a_im, s5_log_dt,
              s5_b_re, s5_b_im, s5_c_re, s5_c_im, s5_d, s5_w_glu, m_conv_w, m_conv_b,
              m_wq, m_wk, m_wv, m_wo, m_w_if, m_b_if, m_norm_g, m_skip, ev_w_out, od_w_in,
              od_q_norm_g, od_k_norm_g, od_sinks, od_w_out):
    h = x.astype(F32)
    for layer in range(DEPTH):
        shift, scale, gate = adaln(c, ada_w[layer], ada_b[layer])
        hn = rmsnorm(h, norm_g[layer]) * (1.0 + scale) + shift
        if layer % 2 == 0:
            e = layer // 2
            y = s5_mlstm_layer(hn, ev_w_in[e], s5_a_re[e], s5_a_im[e], s5_log_dt[e], s5_b_re[e], s5_b_im[e],
                               s5_c_re[e], s5_c_im[e], s5_d[e], s5_w_glu[e], m_conv_w[e], m_conv_b[e],
                               m_wq[e], m_wk[e], m_wv[e], m_wo[e], m_w_if[e], m_b_if[e], m_norm_g[e],
                               m_skip[e], ev_w_out[e])
        else:
            o = layer // 2
            y = swa_layer(hn, positions, od_w_in[o], od_q_norm_g[o], od_k_norm_g[o], od_sinks[o], od_w_out[o])
        h = h + gate * y
    return h.astype(x.dtype)
```

```cpp
#include <hip/hip_runtime.h>
#include <cstdio>
#include <cstdint>
#include <cstring>
#include <cmath>
namespace pg8 {
#define PG8_LAS __attribute__((address_space(3)))
typedef unsigned short bf16_t;
typedef short bf16x8 __attribute__((ext_vector_type(8)));
typedef float f32x4 __attribute__((ext_vector_type(4)));
typedef unsigned u32x4 __attribute__((ext_vector_type(4)));
typedef unsigned u32x2 __attribute__((ext_vector_type(2)));
constexpr int BM = 256, BK = 64, HALF = 128, HTB = HALF * BK * 2  , STAGE_BYTES = 8 * HTB, NXCD = 8;

__host__ __device__ __forceinline__ int lds_byte(int r, int c) { const int st = (r >> 4) * 2 + (c >> 5), rr = r & 15, cc = c & 31, ob = rr * 64 + cc * 2; return st * 1024 + (ob ^ (((ob >> 9) & 1) << 5)); }
__host__ __device__ __forceinline__ void stage_rc(int b, int& R, int& C) { const int st = b / 1024, sb = b % 1024, swz = sb ^ (((sb >> 9) & 1) << 5); R = (st >> 1) * 16 + swz / 64; C = (st & 1) * 32 + (swz % 64) / 2; }
__host__ __device__ __forceinline__ int perm32(int rho) { const int n = rho >> 4, i = rho & 15; return 8 * (i >> 2) + 4 * n + (i & 3); }

constexpr int UF_ZERO = 1, UF_EPI = 2, UF_MID = 4;
struct Unit { const char* A; const char* B; int pm, pn, z, flags, lda, ldb, K, kind; };

__device__ __forceinline__ int tidx(int wv0) { unsigned ones_ = ~0u; asm volatile("" : "+s"(ones_)); return (wv0 << 6) | (int)__builtin_amdgcn_mbcnt_hi(ones_, __builtin_amdgcn_mbcnt_lo(ones_, 0u)); }
__device__ __forceinline__ unsigned cvt_pk_bf16(float lo, float hi) { unsigned r; asm volatile("s_nop 0\n\tv_cvt_pk_bf16_f32 %0, %1, %2" : "=v"(r) : "v"(lo), "v"(hi)); return r; }

template <class F> struct Epi8 {
    static constexpr bool PERM = true;
    static constexpr int NV = F::NV;
    F f;
    __device__ __forceinline__ void mid(f32x4 (&)[2][2][4][2], const Unit&, int, int, int, int) const {}
    __device__ __forceinline__ void operator()(const f32x4 (&acc)[2][2][4][2], const Unit& u, int wr, int wc, int fr, int fq) const {
#pragma unroll
        for (int ai = 0; ai < 2; ++ai)
#pragma unroll
            for (int m = 0; m < 4; ++m) {
#pragma unroll
                for (int bj = 0; bj < 2; ++bj) f(u, ai * HALF + wr * 64 + m * 16 + fr, bj * HALF + wc * 32 + 8 * fq, acc[ai][bj][m][0], acc[ai][bj][m][1]);
                }
    }
};
template <class F> struct Epi4 {
    static constexpr bool PERM = false;
    static constexpr int NV = 0;
    F f;
    __device__ __forceinline__ void mid(f32x4 (&)[2][2][4][2], const Unit&, int, int, int, int) const {}
    __device__ __forceinline__ void operator()(const f32x4 (&acc)[2][2][4][2], const Unit& u, int wr, int wc, int fr, int fq) const {
#pragma unroll
        for (int ai = 0; ai < 2; ++ai)
#pragma unroll
            for (int m = 0; m < 4; ++m) {
#pragma unroll
                for (int bj = 0; bj < 2; ++bj)
#pragma unroll
                    for (int n = 0; n < 2; ++n) f(u, ai * HALF + wr * 64 + m * 16 + fr, bj * HALF + wc * 32 + n * 16 + 4 * fq, acc[ai][bj][m][n]);
                }
    }
};

template <class S0> struct Strided { S0 s0; int G, c; __device__ __forceinline__ bool next(int i, Unit& u) const { return s0.at(i * G + c, u); } };
template <class S0, class S1> struct Strided2 { S0 s0; S1 s1; int n0, G, c;
    __device__ __forceinline__ bool next(int i, Unit& u) const { const int L = i * G + c; if (L < n0) return s0.at(L, u); const bool ok = s1.at(L - n0, u); u.kind = 1; return ok; } };
template <class S0, class S1, class S2> struct Strided3 { S0 s0; S1 s1; S2 s2; int n0, n1, G, c;
    __device__ __forceinline__ bool next(int i, Unit& u) const { const int L = i * G + c; if (L < n0) return s0.at(L, u); if (L < n0 + n1) { const bool ok = s1.at(L - n0, u); u.kind = 1; return ok; } const bool ok = s2.at(L - n0 - n1, u); u.kind = 2; return ok; } };
template <class E0, class E1, bool SEAM_OK = true> struct EpiSel2 { static constexpr bool PERM = E0::PERM; static constexpr int NV = SEAM_OK ? (E0::NV < E1::NV ? E0::NV : E1::NV) : 0;     static_assert(E0::PERM == E1::PERM, "PERM"); E0 e0; E1 e1;
    __device__ __forceinline__ void mid(f32x4 (&)[2][2][4][2], const Unit&, int, int, int, int) const {}
    __device__ __forceinline__ void operator()(const f32x4 (&acc)[2][2][4][2], const Unit& u, int wr, int wc, int fr, int fq) const { if (u.kind == 0) e0(acc, u, wr, wc, fr, fq); else e1(acc, u, wr, wc, fr, fq); } };
template <class E0, class E1, class E2> struct EpiSel3 { static constexpr bool PERM = E0::PERM; static constexpr int NV = (E0::NV < E1::NV ? E0::NV : E1::NV) < E2::NV ? (E0::NV < E1::NV ? E0::NV : E1::NV) : E2::NV; static_assert(E0::PERM == E1::PERM && E0::PERM == E2::PERM, "PERM"); E0 e0; E1 e1; E2 e2;
    __device__ __forceinline__ void mid(f32x4 (&)[2][2][4][2], const Unit&, int, int, int, int) const {}
    __device__ __forceinline__ void operator()(const f32x4 (&acc)[2][2][4][2], const Unit& u, int wr, int wc, int fr, int fq) const { if (u.kind == 0) e0(acc, u, wr, wc, fr, fq); else if (u.kind == 1) e1(acc, u, wr, wc, fr, fq); else e2(acc, u, wr, wc, fr, fq); } };

template <class Epi, class Sched>
__device__ __forceinline__ void gemm_phase(PG8_LAS unsigned char* lds, const Sched& S, const Epi& E, int wv0) {
    int tid_ = tidx(wv0); asm volatile("" : "+v"(tid_));
    const int tid = tid_, wid = __builtin_amdgcn_readfirstlane(tid >> 6), lane = tid & 63, wr = wid >> 2, wc = wid & 3, fr = lane & 15, fq = lane >> 4;
    constexpr bool SEAM = Epi::NV >= 16;
    int Ra[2], Ca[2], Rb[2];
#pragma unroll
    for (int i = 0; i < 2; ++i) { int R, C; stage_rc(tid * 16 + i * 8192, R, C); Ra[i] = R; Ca[i] = C; Rb[i] = Epi::PERM ? ((R & ~31) + perm32(R & 31)) : R; }
    unsigned voffA[2], voffB[2];
    const size_t kstep = (size_t)(BK * 2);
    size_t hstepA, hstepB;
#define PG8_SETV(u) do { if (SEAM) { const int _tid = tidx(wv0); _Pragma("unroll") for (int _i = 0; _i < 2; ++_i) { int _R, _C; stage_rc(_tid * 16 + _i * 8192, _R, _C); const int _Rb = Epi::PERM ? ((_R & ~31) + perm32(_R & 31)) : _R; \
            voffA[_i] = (unsigned)(_R * (u).lda + _C) * 2u; voffB[_i] = (unsigned)(_Rb * (u).ldb + _C) * 2u; } } \
        else { _Pragma("unroll") for (int _i = 0; _i < 2; ++_i) { voffA[_i] = (unsigned)(Ra[_i] * (u).lda + Ca[_i]) * 2u; voffB[_i] = (unsigned)(Rb[_i] * (u).ldb + Ca[_i]) * 2u; } } \
        hstepA = (size_t)HALF * (u).lda * 2; hstepB = (size_t)HALF * (u).ldb * 2; } while (0)
    const unsigned ldsw = (unsigned)wid * 1024u;
    const int aoff = lds_byte(wr * 64 + fr, fq * 8), boff = lds_byte(wc * 32 + fr, fq * 8);
#define PG8_SA(b, h) (((b) * 2 + (h)) * HTB)
#define PG8_SB(b, h) ((4 + (b) * 2 + (h)) * HTB)
#define PG8_STAGE(bufoff, gbase, voff) do { _Pragma("unroll") for (int _i = 0; _i < 2; ++_i) \
        __builtin_amdgcn_global_load_lds((const unsigned*)((const char*)(gbase) + (voff)[_i]), (PG8_LAS unsigned*)(lds + (bufoff) + ldsw + _i * 8192), 16, 0, 0); } while (0)
#define PG8_LDA(dst, b, h) do { _Pragma("unroll") for (int m = 0; m < 4; ++m) _Pragma("unroll") for (int k = 0; k < 2; ++k) dst[m][k] = *(const PG8_LAS bf16x8*)(lds + PG8_SA(b, h) + aoff + m * 2048 + k * 1024); } while (0)
#define PG8_LDB(dst, b, h) do { _Pragma("unroll") for (int n = 0; n < 2; ++n) _Pragma("unroll") for (int k = 0; k < 2; ++k) dst[n][k] = *(const PG8_LAS bf16x8*)(lds + PG8_SB(b, h) + boff + n * 2048 + k * 1024); } while (0)
#define PG8_MMA(ai, bj, At, Bt) do { __builtin_amdgcn_s_setprio(1); _Pragma("unroll") for (int m = 0; m < 4; ++m) _Pragma("unroll") for (int n = 0; n < 2; ++n) _Pragma("unroll") for (int k = 0; k < 2; ++k) \
        acc[ai][bj][m][n] = __builtin_amdgcn_mfma_f32_16x16x32_bf16(Bt[n][k], At[m][k], acc[ai][bj][m][n], 0, 0, 0); __builtin_amdgcn_s_setprio(0); } while (0)
#define PG8_WAIT_V(n) asm volatile("s_waitcnt vmcnt(" #n ")" ::: "memory")
#define PG8_WAIT_L(n) asm volatile("s_waitcnt lgkmcnt(" #n ")" ::: "memory")
#define PG8_BAR __builtin_amdgcn_s_barrier()
#define PG8_SCHED __builtin_amdgcn_sched_barrier(0)
    Unit cur, nxt; int ui = 0;
    if (!S.next(0, cur)) return;
    f32x4 acc[2][2][4][2];
#pragma unroll
    for (int a = 0; a < 2; ++a)
#pragma unroll
        for (int b = 0; b < 2; ++b)
#pragma unroll
            for (int m = 0; m < 4; ++m)
#pragma unroll
                for (int n = 0; n < 2; ++n) acc[a][b][m][n] = (f32x4){0.f, 0.f, 0.f, 0.f};
    bf16x8 At[4][2], B0[2][2], B1[2][2];
    const char* cA = cur.A; const char* cB = cur.B;
    PG8_SETV(cur);
    PG8_STAGE(PG8_SB(0, 0), cB, voffB); PG8_STAGE(PG8_SB(0, 1), cB + hstepB, voffB); PG8_STAGE(PG8_SA(0, 0), cA, voffA); PG8_STAGE(PG8_SA(0, 1), cA + hstepA, voffA);
    if (wr == 1) PG8_BAR;
    PG8_WAIT_V(2); PG8_BAR;
    PG8_STAGE(PG8_SB(1, 0), cB + kstep, voffB); PG8_STAGE(PG8_SA(1, 0), cA + kstep, voffA); PG8_STAGE(PG8_SB(1, 1), cB + hstepB + kstep, voffB);
    PG8_WAIT_V(6); PG8_BAR;
    bool pre = false, relax = false;
    for (;;) {
        const bool has_next = S.next(ui + 1, nxt);
        const char* nA = has_next ? nxt.A : cA; const char* nB = has_next ? nxt.B : cB;
        const int nt = cur.K / BK;
        for (int t = 0; t < nt; t += 2) {
            const bool last = (t == nt - 2);
            const char* a1 = cA + (size_t)(t + 1) * kstep;
            const char* a2 = last ? nA : cA + (size_t)(t + 2) * kstep; const char* b2 = last ? nB : cB + (size_t)(t + 2) * kstep;
            const char* a3 = a2 + kstep; const char* b3 = b2 + kstep;
            const bool rx = relax && (t == 0);
            PG8_LDB(B0, 0, 0); PG8_LDB(B1, 0, 1); PG8_SCHED; PG8_LDA(At, 0, 0); if (!(pre && t == 0)) PG8_STAGE(PG8_SA(1, 1), a1 + hstepA, voffA);
            if (rx) PG8_WAIT_V(24); else PG8_WAIT_V(8);
            PG8_WAIT_L(0); PG8_BAR; PG8_MMA(0, 0, At, B0); PG8_MMA(0, 1, At, B1); PG8_BAR; PG8_SCHED;
            if (last && has_next) PG8_SETV(nxt);
            PG8_LDA(At, 0, 1); PG8_STAGE(PG8_SB(0, 0), b2, voffB); PG8_STAGE(PG8_SB(0, 1), b2 + hstepB, voffB); PG8_STAGE(PG8_SA(0, 0), a2, voffA);
            if (rx) PG8_WAIT_V(24); else PG8_WAIT_V(8);
            PG8_WAIT_L(0); PG8_BAR; PG8_MMA(1, 0, At, B0); PG8_MMA(1, 1, At, B1); PG8_BAR; PG8_SCHED;
            PG8_LDB(B0, 1, 0); PG8_LDB(B1, 1, 1); PG8_SCHED; PG8_LDA(At, 1, 0); PG8_STAGE(PG8_SA(0, 1), a2 + hstepA, voffA);
            if (rx) PG8_WAIT_V(24); else PG8_WAIT_V(8);
            PG8_WAIT_L(0); PG8_BAR; PG8_MMA(0, 0, At, B0); PG8_MMA(0, 1, At, B1); PG8_BAR; PG8_SCHED;
            PG8_LDA(At, 1, 1); PG8_STAGE(PG8_SB(1, 0), b3, voffB); PG8_STAGE(PG8_SB(1, 1), b3 + hstepB, voffB); PG8_STAGE(PG8_SA(1, 0), a3, voffA);
            PG8_WAIT_V(8); PG8_WAIT_L(0); PG8_BAR; PG8_MMA(1, 0, At, B0); PG8_MMA(1, 1, At, B1); PG8_BAR; PG8_SCHED;
        }
        if (wr == 0) PG8_BAR;
        if (SEAM && has_next) PG8_STAGE(PG8_SA(1, 1), nA + kstep + hstepA, voffA);
        { unsigned ones_ = ~0u; asm volatile("" : "+s"(ones_)); const int lid_ = (int)__builtin_amdgcn_mbcnt_hi(ones_, __builtin_amdgcn_mbcnt_lo(ones_, 0u));
          const int fr_ = lid_ & 15, fq_ = lid_ >> 4;
          if (cur.flags & UF_EPI) E(acc, cur, wr, wc, fr_, fq_);
          if (cur.flags & UF_MID) E.mid(acc, cur, wr, wc, fr_, fq_); }
        if (!has_next) break;
        if (nxt.flags & UF_ZERO) {
#pragma unroll
        for (int a = 0; a < 2; ++a)
#pragma unroll
            for (int b = 0; b < 2; ++b)
#pragma unroll
                for (int m = 0; m < 4; ++m)
#pragma unroll
                    for (int n = 0; n < 2; ++n) acc[a][b][m][n] = (f32x4){0.f, 0.f, 0.f, 0.f};
        }
        pre = SEAM; relax = SEAM && (cur.flags & UF_EPI);
        cur = nxt; cA = nA; cB = nB; ++ui;
        if (wr == 1) PG8_BAR;
    }
    PG8_WAIT_V(0);
    PG8_BAR;
#undef PG8_SA
#undef PG8_SETV
#undef PG8_SB
#undef PG8_STAGE
#undef PG8_LDA
#undef PG8_LDB
#undef PG8_MMA
#undef PG8_WAIT_V
#undef PG8_WAIT_L
#undef PG8_BAR
#undef PG8_SCHED
}
}
typedef unsigned short bf16;
typedef float f32x4 __attribute__((ext_vector_type(4)));
typedef unsigned u32x4 __attribute__((ext_vector_type(4)));
typedef unsigned u32x2 __attribute__((ext_vector_type(2)));
constexpr int DM = 1024, NB = 16, SEQ = 4096, MTOK = NB * SEQ, MH = MTOK / 2, DEPTH = 4;
constexpr float EPS = 1e-6f;
constexpr size_t MiB = 1u << 20;
constexpr size_t WS_CTL = 0;
constexpr size_t WS_MOD = 1 * MiB;
constexpr size_t WS_W_EIN = 4 * MiB;
constexpr size_t WS_W_GLU = 20 * MiB;
constexpr size_t WS_W_Q = 24 * MiB, WS_W_K = 25 * MiB, WS_W_V = 26 * MiB, WS_W_O = 27 * MiB;
constexpr size_t WS_W_EOUT = 28 * MiB;
constexpr size_t WS_W_OIN = 36 * MiB;
constexpr size_t WS_W_OOUT = 46 * MiB;
constexpr size_t WS_HN = 64 * MiB;
constexpr size_t WS_PROJ = 192 * MiB;
constexpr size_t WS_Y2 = 448 * MiB;
constexpr size_t WS_YCAT = 512 * MiB;
constexpr size_t WS_XC = 640 * MiB;
constexpr size_t WS_Q = 704 * MiB, WS_K = 768 * MiB, WS_V = 832 * MiB, WS_O = 896 * MiB;
constexpr size_t WS_LI = 960 * MiB, WS_LF = 961 * MiB;
constexpr size_t WS_END = 962 * MiB;

__device__ __forceinline__ float bf2f(unsigned u) { return __uint_as_float(u << 16); }
__device__ __forceinline__ float bflo(unsigned w) { return __uint_as_float(w << 16); }
__device__ __forceinline__ float bfhi(unsigned w) { return __uint_as_float(w & 0xffff0000u); }
__device__ __forceinline__ unsigned pk2(float lo, float hi) { return pg8::cvt_pk_bf16(lo, hi); }
__device__ __forceinline__ bf16 f2bf(float f) { return (bf16)(pg8::cvt_pk_bf16(f, 0.f) & 0xffffu); }
__device__ __forceinline__ float silu_f(float x) { return x * __builtin_amdgcn_rcpf(1.f + __expf(-x)); }
__device__ __forceinline__ float sigmoid_f(float x) { return __builtin_amdgcn_rcpf(1.f + __expf(-x)); }
__device__ __forceinline__ float gelu_tanh_f(float x) { const float u2 = 1.5957691216057308f * (x + 0.044715f * x * x * x); return x * __builtin_amdgcn_rcpf(1.f + __expf(-u2)); }
__device__ __forceinline__ float log_sigmoid_f(float x) { return fminf(x, 0.f) - 0.6931471805599453f * __builtin_amdgcn_logf(1.f + __expf(-fabsf(x))); }
__device__ __forceinline__ int tidx(int wv0) { unsigned ones_ = ~0u; asm volatile("" : "+s"(ones_)); return (wv0 << 6) | (int)__builtin_amdgcn_mbcnt_hi(ones_, __builtin_amdgcn_mbcnt_lo(ones_, 0u)); }
template <int CTRL> __device__ __forceinline__ float dpp_t(float v) { return __uint_as_float((unsigned)__builtin_amdgcn_mov_dpp((int)__float_as_uint(v), CTRL, 0xF, 0xF, true)); }
#define dpp_f(v, ctrl) dpp_t<ctrl>(v)
#define DPP_XOR1 0xB1
#define DPP_XOR2 0x4E
#define DPP_HMIRROR 0x141
#define DPP_MIRROR 0x140
__device__ __forceinline__ float sum_x16(float v) { auto r = __builtin_amdgcn_permlane16_swap(__float_as_uint(v), __float_as_uint(v), false, false); return __uint_as_float(r[0]) + __uint_as_float(r[1]); }
__device__ __forceinline__ float sum_x32(float v) { auto r = __builtin_amdgcn_permlane32_swap(__float_as_uint(v), __float_as_uint(v), false, false); return __uint_as_float(r[0]) + __uint_as_float(r[1]); }
__device__ __forceinline__ float max_x16(float v) { auto r = __builtin_amdgcn_permlane16_swap(__float_as_uint(v), __float_as_uint(v), false, false); return fmaxf(__uint_as_float(r[0]), __uint_as_float(r[1])); }
__device__ __forceinline__ float max_x32(float v) { auto r = __builtin_amdgcn_permlane32_swap(__float_as_uint(v), __float_as_uint(v), false, false); return fmaxf(__uint_as_float(r[0]), __uint_as_float(r[1])); }
__device__ __forceinline__ float other_x16(float v, int lane) { auto r = __builtin_amdgcn_permlane16_swap(__float_as_uint(v), __float_as_uint(v), false, false); return __uint_as_float((lane & 16) ? r[0] : r[1]); }
__device__ __forceinline__ float sum_row16(float v) { v += dpp_f(v, DPP_XOR1); v += dpp_f(v, DPP_XOR2); v += dpp_f(v, DPP_HMIRROR); v += dpp_f(v, DPP_MIRROR); return v; }
__device__ __forceinline__ float max_row16(float v) { v = fmaxf(v, dpp_f(v, DPP_XOR1)); v = fmaxf(v, dpp_f(v, DPP_XOR2)); v = fmaxf(v, dpp_f(v, DPP_HMIRROR)); v = fmaxf(v, dpp_f(v, DPP_MIRROR)); return v; }
__device__ __forceinline__ float wave_sum(float v) { return sum_x32(sum_x16(sum_row16(v))); }
__device__ __forceinline__ float wave_max(float v) { return max_x32(max_x16(max_row16(v))); }
namespace w2 {
constexpr size_t CTL = 0, MOD = 1 * MiB, AT16 = 2 * MiB;
constexpr size_t BCUM = 3 * MiB, KAP = BCUM + 512 * 1024, PMX = 4 * MiB, WEXP = PMX + 512 * 1024, BT = 5 * MiB, MLOC = BT + 4096;
constexpr size_t LI = 11 * MiB, LF = LI + 512 * 1024, WIFT = 2 * MiB + 256 * 1024;
constexpr size_t DNP = 6 * MiB, NST = 8 * MiB, DSP = 9 * MiB, ROPE = 12 * MiB;
constexpr size_t W_EIN = 16 * MiB, W_GLU = 32 * MiB, W_Q = 36 * MiB, W_K = 37 * MiB, W_V = 38 * MiB, W_O = 39 * MiB, W_EOUT = 40 * MiB, W_OIN = 48 * MiB, W_OOUT = 58 * MiB;
constexpr size_t KC = 62 * MiB, BMAT = 86 * MiB;
constexpr size_t HN = 104 * MiB;
constexpr size_t AU = 168 * MiB;
constexpr size_t ZS = 264 * MiB, MIN = 328 * MiB  , MZS = 392 * MiB, XC = 456 * MiB, Q = 520 * MiB, K = 584 * MiB, O = 648 * MiB;
constexpr size_t KWT = 712 * MiB  , VT = 776 * MiB, CT = 840 * MiB, Z = 904 * MiB  , ZINC = 968 * MiB  , END = 1000 * MiB;
constexpr size_t QO = 232 * MiB, KO = 360 * MiB, VTG = 392 * MiB, ZO = 424 * MiB, ABUF = 840 * MiB;
constexpr size_t HC = K;
static_assert(MIN == ZS + 64 * MiB && MZS == ZS + 128 * MiB && K == Q + 64 * MiB && O == Q + 128 * MiB && VT == KWT + 64 * MiB && W_K == W_Q + MiB && W_V == W_K + MiB && W_O == W_Q + 3 * MiB, "offset arithmetic in the schedules");
}
constexpr int S5T = 16, AUP = 384, S5ROWS = (MH / S5T);

__device__ __forceinline__ void s5_build_mats(unsigned char* smem, int eg, const float* a_re, const float* a_im, const float* log_dt, const float* b_re, const float* b_im,
                                              const float* c_re, const float* c_im, const float* d_skip, bf16* KC, bf16* BMAT, float* AT16, int wv0) {
    float* pwr = (float*)smem; float* pwi = pwr + 17 * 64; float* bbr = pwi + 17 * 64; float* bbi = bbr + 1024; float* kt = bbi + 1024;
    int tid_ = tidx(wv0); asm volatile("" : "+v"(tid_)); const int tid = tid_, g = eg & 63;
    const float* are = a_re + eg * 64; const float* aim = a_im + eg * 64; const float* bre = b_re + (size_t)eg * 1024; const float* bim = b_im + (size_t)eg * 1024;
    const float* cre = c_re + (size_t)eg * 1024; const float* cim = c_im + (size_t)eg * 1024;
    (void)g;
    if (tid < 64) {
        const int n = tid;
        const double dt = exp((double)log_dt[eg]);
        const double ar = are[n], ai = aim[n];
        for (int k = 0; k <= 16; ++k) { const double er = exp(ar * dt * k); pwr[k * 64 + n] = (float)(er * cos(ai * dt * k)); pwi[k * 64 + n] = (float)(er * sin(ai * dt * k)); }
        const double er = exp(ar * dt), abr = er * cos(ai * dt), abi = er * sin(ai * dt);
        const double nr = abr - 1.0, ni = abi, den = ar * ar + ai * ai;
        const double fr = (nr * ar + ni * ai) / den, fi = (ni * ar - nr * ai) / den;
        for (int q = 0; q < 16; ++q) { const double br = bre[n * 16 + q], bi = bim[n * 16 + q]; bbr[n * 16 + q] = (float)(fr * br - fi * bi); bbi[n * 16 + q] = (float)(fr * bi + fi * br); }
        AT16[(size_t)eg * 128 + 2 * n] = pwr[16 * 64 + n]; AT16[(size_t)eg * 128 + 2 * n + 1] = pwi[16 * 64 + n];
    }
    __syncthreads();
    for (int idx = tid; idx < 16 * 256; idx += 512) {
        const int tau = idx >> 8, p = (idx >> 4) & 15, q = idx & 15;
        float s = 0.f;
        for (int n = 0; n < 64; ++n) { const float cr = cre[p * 64 + n], ci = cim[p * 64 + n], wr = pwr[tau * 64 + n], wi = pwi[tau * 64 + n];
            const float xr = cr * wr - ci * wi, xi = cr * wi + ci * wr;
            s += xr * bbr[n * 16 + q] - xi * bbi[n * 16 + q]; }
        kt[idx] = s + ((tau == 0 && p == q) ? d_skip[eg * 16 + p] : 0.f);
    }
    __syncthreads();
    bf16* kc = KC + (size_t)eg * 256 * AUP; bf16* bm = BMAT + (size_t)eg * 256 * 256;
    for (int idx = tid; idx < 256 * 256; idx += 512) {
        const int row = idx >> 8, col = idx & 255, j = row >> 4, p = row & 15, i = col >> 4, q = col & 15;
        kc[(size_t)row * AUP + col] = (i <= j) ? f2bf(kt[((j - i) << 8) + p * 16 + q]) : (bf16)0;
    }
    for (int idx = tid; idx < 256 * 64; idx += 512) {
        const int row = idx >> 6, n = idx & 63, j = row >> 4, p = row & 15;
        const float cr = cre[p * 64 + n], ci = cim[p * 64 + n], wr = pwr[(j + 1) * 64 + n], wi = pwi[(j + 1) * 64 + n];
        kc[(size_t)row * AUP + 256 + n] = f2bf(cr * wr - ci * wi); kc[(size_t)row * AUP + 320 + n] = f2bf(-(cr * wi + ci * wr));
    }
    for (int idx = tid; idx < 256 * 256; idx += 512) {
        const int row = idx >> 8, col = idx & 255, i = col >> 4, q = col & 15;
        float v = 0.f;
        if (row < 128) { const int n = row & 63; const float wr = pwr[(15 - i) * 64 + n], wi = pwi[(15 - i) * 64 + n], br = bbr[n * 16 + q], bi = bbi[n * 16 + q];
            v = (row < 64) ? (wr * br - wi * bi) : (wr * bi + wi * br); }
        bm[(size_t)row * 256 + col] = f2bf(v);
    }
    __syncthreads();
}

__device__ __forceinline__ void s5_scan_items(float* sm  , int cwg, int G, int tid, const float* AT16e, const bf16* Z, bf16* AU) {
    asm volatile("" : "+v"(tid));
    const int lane = tid & 63, w = __builtin_amdgcn_readfirstlane(tid >> 6);
    __syncthreads();
    for (int it = cwg; it < 512; it += 2 * G) {
        const int combo = min(it + G * (lane >> 5), 511), g = combo >> 3, bl = combo & 7, p = lane & 31; const bool live = it + G * (lane >> 5) < 512;
        const f32x4 a = *(const f32x4*)(AT16e + g * 128 + 4 * p);
        const size_t row0 = (size_t)g * S5ROWS + (size_t)bl * 256 + w * 32;
        const unsigned* zp = (const unsigned*)(Z + row0 * 128) + p;
        unsigned zr[32], zi[32];
#pragma unroll
        for (int k = 0; k < 32; ++k) { zr[k] = zp[k * 64]; zi[k] = zp[k * 64 + 32]; }
        __builtin_amdgcn_sched_barrier(0);
        float s0r = 0.f, s0i = 0.f, s1r = 0.f, s1i = 0.f;
#pragma unroll
        for (int k = 0; k < 32; ++k) {
            unsigned wr_ = zr[k], wi_ = zi[k]; asm volatile("" : "+v"(s0r), "+v"(wr_), "+v"(wi_));
            const float n0r = a.x * s0r - a.y * s0i + bflo(wr_), n0i = a.x * s0i + a.y * s0r + bflo(wi_);
            const float n1r = a.z * s1r - a.w * s1i + bfhi(wr_), n1i = a.z * s1i + a.w * s1r + bfhi(wi_);
            s0r = n0r; s0i = n0i; s1r = n1r; s1i = n1i;
        }
        float q0r = a.x, q0i = a.y, q1r = a.z, q1i = a.w;
#pragma unroll
        for (int j = 0; j < 5; ++j) { const float t0 = q0r * q0r - q0i * q0i, t1 = 2.f * q0r * q0i, t2 = q1r * q1r - q1i * q1i, t3 = 2.f * q1r * q1i; q0r = t0; q0i = t1; q1r = t2; q1i = t3; }
        *(f32x4*)(sm + (w * 64 + lane) * 4) = (f32x4){s0r, s0i, s1r, s1i};
        __syncthreads();
        s0r = 0.f; s0i = 0.f; s1r = 0.f; s1i = 0.f;
        for (int j = 0; j < w; ++j) { const f32x4 e = *(const f32x4*)(sm + (j * 64 + lane) * 4);
            const float n0r = q0r * s0r - q0i * s0i + e.x, n0i = q0r * s0i + q0i * s0r + e.y, n1r = q1r * s1r - q1i * s1i + e.z, n1i = q1r * s1i + q1i * s1r + e.w;
            s0r = n0r; s0i = n0i; s1r = n1r; s1i = n1i; }
        unsigned* sp = (unsigned*)(AU + row0 * AUP + 256) + p;
#pragma unroll
        for (int k = 0; k < 32; ++k) {
            unsigned wr_ = zr[k], wi_ = zi[k]; asm volatile("" : "+v"(s0r), "+v"(wr_), "+v"(wi_));
            if (live) { sp[k * (AUP / 2)] = pk2(s0r, s1r); sp[k * (AUP / 2) + 32] = pk2(s0i, s1i); }
            const float n0r = a.x * s0r - a.y * s0i + bflo(wr_), n0i = a.x * s0i + a.y * s0r + bflo(wi_);
            const float n1r = a.z * s1r - a.w * s1i + bfhi(wr_), n1i = a.z * s1i + a.w * s1r + bfhi(wi_);
            s0r = n0r; s0i = n0i; s1r = n1r; s1i = n1i;
        }
        __syncthreads();
    }
}
constexpr int NTILE = MH / 256;
constexpr int NUNIT = NTILE * 4;

typedef short bf16x8_m __attribute__((ext_vector_type(8)));
constexpr int GT_WP = 4112;
constexpr int GT_CW_OFF = 16 * GT_WP;
__device__ __forceinline__ void mlstm_gates_stage(unsigned char* sm, const float* __restrict__ conv_w, const float* __restrict__ conv_b, const bf16* __restrict__ WIFT, int wv0) {
    int tid_ = tidx(wv0); asm volatile("" : "+v"(tid_)); const int tid = tid_;
    for (int p = tid; p < 16 * 256; p += 512) { const int n = p >> 8, part = p & 255; *(u32x4*)(sm + n * GT_WP + part * 16) = *(const u32x4*)(WIFT + (size_t)n * 2048 + part * 8); }
    for (int p = tid; p < 1280; p += 512) { const f32x4 v = (p < 1024) ? *(const f32x4*)(conv_w + p * 4) : *(const f32x4*)(conv_b + (p - 1024) * 4); *(f32x4*)(sm + GT_CW_OFF + p * 16) = v; }
    __syncthreads();
}
__device__ __forceinline__ void mlstm_gates_unit(const unsigned char* sm, int unit, const bf16* __restrict__ MIN, const float* __restrict__ b_if, bf16* __restrict__ XC, float* __restrict__ LI, float* __restrict__ LF, int wv0) {
    int tid_ = tidx(wv0); asm volatile("" : "+v"(tid_)); const int tid = tid_, lane = tid & 63, wv = tid >> 6, l15 = lane & 15, kg = lane >> 4;
    const int row = unit * 128 + wv * 16 + l15, t = row & (SEQ - 1);
    pg8::f32x4 acc = (pg8::f32x4){0.f, 0.f, 0.f, 0.f};
    const bf16* mp = MIN + (size_t)row * 1024 + kg * 8;
    const unsigned char* wp = sm + l15 * GT_WP + kg * 16;
    const float* cw = (const float*)(sm + GT_CW_OFF) + kg * 8;
    const bool halo = (l15 < 3) && ((row - l15) & (SEQ - 1)) != 0;
    const bf16* hp = halo ? mp - (size_t)(2 * l15 + 1) * 1024 : mp;
    (void)t;
    u32x4 xa[8], ha[8], xb[8], hb[8];
    auto step = [&](const u32x4 x0, const u32x4 hraw, const int ks) {
        const int c0 = ks * 32 + kg * 8;
        const u32x4 z4 = (u32x4){0u, 0u, 0u, 0u};
        const u32x4 hx = halo ? hraw : z4;
        u32x4 x1, x2, x3;
#define GT_SHR(n, v) (unsigned)__builtin_amdgcn_mov_dpp((int)(v), 0x110 + (n), 0xF, 0xF, true)
#define GT_QP(c, v)  (unsigned)__builtin_amdgcn_mov_dpp((int)(v), (c), 0xF, 0xF, true)
        u32x4 s1, s2, s3, h2, h3;
        s1.x = GT_SHR(1, x0.x); s1.y = GT_SHR(1, x0.y); s1.z = GT_SHR(1, x0.z); s1.w = GT_SHR(1, x0.w);
        s2.x = GT_SHR(2, x0.x); s2.y = GT_SHR(2, x0.y); s2.z = GT_SHR(2, x0.z); s2.w = GT_SHR(2, x0.w);
        s3.x = GT_SHR(3, x0.x); s3.y = GT_SHR(3, x0.y); s3.z = GT_SHR(3, x0.z); s3.w = GT_SHR(3, x0.w);
        h2.x = GT_QP(0xB1, hx.x); h2.y = GT_QP(0xB1, hx.y); h2.z = GT_QP(0xB1, hx.z); h2.w = GT_QP(0xB1, hx.w);
        h3.x = GT_QP(0xC6, hx.x); h3.y = GT_QP(0xC6, hx.y); h3.z = GT_QP(0xC6, hx.z); h3.w = GT_QP(0xC6, hx.w);
        x1 = (l15 >= 1) ? s1 : hx; x2 = (l15 >= 2) ? s2 : h2; x3 = (l15 >= 3) ? s3 : h3;
#undef GT_SHR
#undef GT_QP
        const bf16x8_m bx = *(const bf16x8_m*)(wp + ks * 64), bm = *(const bf16x8_m*)(wp + 2048 + ks * 64);
        f32x4 a0 = *(const f32x4*)(cw + 4096 + ks * 32), a1 = *(const f32x4*)(cw + 4096 + ks * 32 + 4);
        { const f32x4 w0 = *(const f32x4*)(cw + 3 * 1024 + ks * 32), w1 = *(const f32x4*)(cw + 3 * 1024 + ks * 32 + 4);
          a0 += (f32x4){bflo(x0.x), bfhi(x0.x), bflo(x0.y), bfhi(x0.y)} * w0; a1 += (f32x4){bflo(x0.z), bfhi(x0.z), bflo(x0.w), bfhi(x0.w)} * w1; }
        { const f32x4 w0 = *(const f32x4*)(cw + 2 * 1024 + ks * 32), w1 = *(const f32x4*)(cw + 2 * 1024 + ks * 32 + 4);
          a0 += (f32x4){bflo(x1.x), bfhi(x1.x), bflo(x1.y), bfhi(x1.y)} * w0; a1 += (f32x4){bflo(x1.z), bfhi(x1.z), bflo(x1.w), bfhi(x1.w)} * w1; }
        { const f32x4 w0 = *(const f32x4*)(cw + 1 * 1024 + ks * 32), w1 = *(const f32x4*)(cw + 1 * 1024 + ks * 32 + 4);
          a0 += (f32x4){bflo(x2.x), bfhi(x2.x), bflo(x2.y), bfhi(x2.y)} * w0; a1 += (f32x4){bflo(x2.z), bfhi(x2.z), bflo(x2.w), bfhi(x2.w)} * w1; }
        { const f32x4 w0 = *(const f32x4*)(cw + ks * 32), w1 = *(const f32x4*)(cw + ks * 32 + 4);
          a0 += (f32x4){bflo(x3.x), bfhi(x3.x), bflo(x3.y), bfhi(x3.y)} * w0; a1 += (f32x4){bflo(x3.z), bfhi(x3.z), bflo(x3.w), bfhi(x3.w)} * w1; }
        u32x4 xo; xo.x = pk2(silu_f(a0.x), silu_f(a0.y)); xo.y = pk2(silu_f(a0.z), silu_f(a0.w)); xo.z = pk2(silu_f(a1.x), silu_f(a1.y)); xo.w = pk2(silu_f(a1.z), silu_f(a1.w));
        *(u32x4*)(XC + (size_t)row * 1024 + c0) = xo;
        acc = __builtin_amdgcn_mfma_f32_16x16x32_bf16(__builtin_bit_cast(bf16x8_m, xo), bx, acc, 0, 0, 0);
        acc = __builtin_amdgcn_mfma_f32_16x16x32_bf16(__builtin_bit_cast(bf16x8_m, x0), bm, acc, 0, 0, 0);
    };
#pragma unroll
    for (int j = 0; j < 8; ++j) { xa[j] = *(const u32x4*)(mp + j * 32); ha[j] = *(const u32x4*)(hp + j * 32); }
#pragma unroll 1
    for (int kb = 0; kb < 32; kb += 16) {
#pragma unroll
        for (int j = 0; j < 8; ++j) { xb[j] = *(const u32x4*)(mp + (kb + 8 + j) * 32); hb[j] = *(const u32x4*)(hp + (kb + 8 + j) * 32); }
#pragma unroll
        for (int j = 0; j < 8; ++j) step(xa[j], ha[j], kb + j);
        if (kb + 16 < 32) {
#pragma unroll
            for (int j = 0; j < 8; ++j) { xa[j] = *(const u32x4*)(mp + (kb + 16 + j) * 32); ha[j] = *(const u32x4*)(hp + (kb + 16 + j) * 32); }
        }
#pragma unroll
        for (int j = 0; j < 8; ++j) step(xb[j], hb[j], kb + 8 + j);
    }
    if (l15 < 8) {
        const float bias = b_if[l15]; const int r0 = unit * 128 + wv * 16 + 4 * kg;
#pragma unroll
        for (int r = 0; r < 4; ++r) { const float v = acc[r] + bias;
            if (l15 < 4) LI[(size_t)(r0 + r) * 4 + l15] = v; else LF[(size_t)(r0 + r) * 4 + (l15 - 4)] = log_sigmoid_f(v); }
    }
}
__device__ __forceinline__ void mlstm_chunk_scalars(int lane, int pn, int h, const float* __restrict__ LI, const float* __restrict__ LF,
                                                    float* __restrict__ bcum, float* __restrict__ kap, float* __restrict__ pmx, float* __restrict__ wexp, float* __restrict__ BT, float* __restrict__ MLOC) {
    float lfv[4], liv[4], b[4], kp[4], pm[4];
#pragma unroll
    for (int i = 0; i < 4; ++i) { const size_t tk = (size_t)pn * 256 + lane * 4 + i; liv[i] = LI[tk * 4 + h]; lfv[i] = LF[tk * 4 + h]; }
    b[0] = lfv[0]; b[1] = b[0] + lfv[1]; b[2] = b[1] + lfv[2]; b[3] = b[2] + lfv[3];
    float inc = b[3];
#pragma unroll
    for (int o = 1; o < 64; o <<= 1) { const float v = __uint_as_float((unsigned)__builtin_amdgcn_ds_bpermute(((lane - o) & 63) << 2, (int)__float_as_uint(inc))); if (lane >= o) inc += v; }
    const float excl = inc - b[3];
#pragma unroll
    for (int i = 0; i < 4; ++i) { b[i] += excl; kp[i] = liv[i] - b[i]; }
    pm[0] = kp[0]; pm[1] = fmaxf(pm[0], kp[1]); pm[2] = fmaxf(pm[1], kp[2]); pm[3] = fmaxf(pm[2], kp[3]);
    float pinc = pm[3];
#pragma unroll
    for (int o = 1; o < 64; o <<= 1) { const float v = __uint_as_float((unsigned)__builtin_amdgcn_ds_bpermute(((lane - o) & 63) << 2, (int)__float_as_uint(pinc))); if (lane >= o) pinc = fmaxf(pinc, v); }
    float pex = __uint_as_float((unsigned)__builtin_amdgcn_ds_bpermute(((lane - 1) & 63) << 2, (int)__float_as_uint(pinc))); if (lane == 0) pex = -INFINITY;
#pragma unroll
    for (int i = 0; i < 4; ++i) pm[i] = fmaxf(pm[i], pex);
    const float bT = __uint_as_float((unsigned)__builtin_amdgcn_readlane((int)__float_as_uint(b[3]), 63));
    const float ml = wave_max(fmaxf(fmaxf(bT + kp[0], bT + kp[1]), fmaxf(bT + kp[2], bT + kp[3])));
    const size_t o4 = (size_t)h * MH + (size_t)pn * 256 + lane * 4;
    *(f32x4*)(bcum + o4) = (f32x4){b[0], b[1], b[2], b[3]};
    *(f32x4*)(kap + o4) = (f32x4){kp[0], kp[1], kp[2], kp[3]};
    *(f32x4*)(pmx + o4) = (f32x4){pm[0], pm[1], pm[2], pm[3]};
    *(f32x4*)(wexp + o4) = (f32x4){__expf(bT + kp[0] - ml), __expf(bT + kp[1] - ml), __expf(bT + kp[2] - ml), __expf(bT + kp[3] - ml)};
    if (lane == 0) { BT[pn * 4 + h] = bT; MLOC[pn * 4 + h] = ml; }
}

__device__ __forceinline__ float mlstm_mc(const float* __restrict__ BT, const float* __restrict__ MLOC, int pn, int h) {
    unsigned ones_ = ~0u; asm volatile("" : "+s"(ones_));
    const int lid_ = (int)(__builtin_amdgcn_mbcnt_hi(ones_, __builtin_amdgcn_mbcnt_lo(ones_, 0u)));
    const int c = pn & 15, p0 = pn & ~15, l = lid_ & 15;
    const float bt = BT[(p0 + l) * 4 + h], ml = MLOC[(p0 + l) * 4 + h];
    float m = 0.f;
    for (int cc = 0; cc < c; ++cc) m = fmaxf(__uint_as_float((unsigned)__builtin_amdgcn_readlane((int)__float_as_uint(bt), cc)) + m, __uint_as_float((unsigned)__builtin_amdgcn_readlane((int)__float_as_uint(ml), cc)));
    return m;
}

__device__ __forceinline__ void mlstm_scan_items(int gtid, int nthreads, bf16* __restrict__ CT, const float* __restrict__ BT, const float* __restrict__ MLOC, const float* __restrict__ DNP, float* __restrict__ NST) {
    asm volatile("" : "+v"(gtid));
    for (int item = gtid; item < 32 * 256 * 32; item += nthreads) {
        const int dk8 = item & 31, dv = (item >> 5) & 255, bh = item >> 13, bl = bh >> 2, h = bh & 3;
        bf16* p = CT + (((size_t)bl * 16 * 1024 + h * 256 + dv) * 256) + dk8 * 8;
        u32x4 d[16];
#pragma unroll
        for (int c = 0; c < 16; ++c) d[c] = *(const u32x4*)(p + (size_t)c * 1024 * 256);
        float btv[16], mlv[16];
#pragma unroll
        for (int c = 0; c < 16; ++c) { btv[c] = BT[((bl * 16 + c) * 4) + h]; mlv[c] = MLOC[((bl * 16 + c) * 4) + h]; }
        float s[8]; float m = 0.f;
#pragma unroll
        for (int k = 0; k < 8; ++k) s[k] = 0.f;
#pragma unroll
        for (int c = 0; c < 16; ++c) {
            u32x4 w; w.x = pk2(s[0], s[1]); w.y = pk2(s[2], s[3]); w.z = pk2(s[4], s[5]); w.w = pk2(s[6], s[7]);
            *(u32x4*)(p + (size_t)c * 1024 * 256) = w;
            const float bt = btv[c], ml = mlv[c];
            const float mn = fmaxf(bt + m, ml), dec = __expf(bt + m - mn), sc = __expf(ml - mn); m = mn;
            s[0] = dec * s[0] + sc * bflo(d[c].x); s[1] = dec * s[1] + sc * bfhi(d[c].x); s[2] = dec * s[2] + sc * bflo(d[c].y); s[3] = dec * s[3] + sc * bfhi(d[c].y);
            s[4] = dec * s[4] + sc * bflo(d[c].z); s[5] = dec * s[5] + sc * bfhi(d[c].z); s[6] = dec * s[6] + sc * bflo(d[c].w); s[7] = dec * s[7] + sc * bfhi(d[c].w);
        }
    }
    {
        const int G_ = nthreads / 512, cw_ = gtid / 512, t_ = gtid & 511, per = (32 * 256 + G_ - 1) / G_;
        if (t_ < per) { const int item = cw_ * per + t_;
            if (item < 32 * 256) {
                const int dk = item & 255, bh = item >> 8, bl = bh >> 2, h = bh & 3;
                float dn[16], btv[16], mlv[16];
#pragma unroll
                for (int c = 0; c < 16; ++c) { const int U = (bl * 16 + c) * 4 + h;
                    dn[c] = (DNP[((size_t)U * 4 + 0) * 256 + dk] + DNP[((size_t)U * 4 + 1) * 256 + dk]) + (DNP[((size_t)U * 4 + 2) * 256 + dk] + DNP[((size_t)U * 4 + 3) * 256 + dk]);
                    btv[c] = BT[U]; mlv[c] = MLOC[U]; }
                float n = 0.f, m = 0.f;
#pragma unroll
                for (int c = 0; c < 16; ++c) { const int U = (bl * 16 + c) * 4 + h;
                    NST[(size_t)U * 256 + dk] = n;
                    const float mn = fmaxf(btv[c] + m, mlv[c]), dec = __expf(btv[c] + m - mn), sc = __expf(mlv[c] - mn); m = mn;
                    n = dec * n + sc * dn[c]; }
            } }
    }
}
__device__ __forceinline__ void mlstm_qn(float* qn, int G, int cwg, const bf16* __restrict__ Q, const float* __restrict__ NST, int wv0) {
    int tid_ = tidx(wv0); asm volatile("" : "+v"(tid_)); const int tid = tid_, row = tid >> 1, hf = tid & 1;
    for (int ui = 0; ui * G + cwg < NUNIT; ++ui) {
        const int U = ui * G + cwg, pn = U >> 2, h = U & 3;
        const bf16* qp = Q + ((size_t)pn * 256 + row) * 1024 + h * 256 + hf * 128; const float* np = NST + (size_t)U * 256 + hf * 128;
        float s = 0.f;
#pragma unroll
        for (int k = 0; k < 16; ++k) { const u32x4 w = *(const u32x4*)(qp + k * 8); const f32x4 n0 = *(const f32x4*)(np + k * 8), n1 = *(const f32x4*)(np + k * 8 + 4);
            s += (bflo(w.x) * n0.x + bfhi(w.x) * n0.y) + (bflo(w.y) * n0.z + bfhi(w.y) * n0.w) + (bflo(w.z) * n1.x + bfhi(w.z) * n1.y) + (bflo(w.w) * n1.z + bfhi(w.w) * n1.w); }
        s += dpp_f(s, DPP_XOR1);
        if (hf == 0) qn[ui * 256 + row] = s;
    }
    __syncthreads();
}
__host__ __device__ __forceinline__ int oddin_logical_col(int np) { const int tile = np >> 8, p = np & 255; return (tile < 5) ? tile * 256 + 64 * ((p >> 5) & 3) + 32 * (p >> 7) + (p & 31) : np; }

__device__ __forceinline__ void rope_table_items(int gtid, int nthreads, const int* __restrict__ positions, float* __restrict__ ROPE) {
    asm volatile("" : "+v"(gtid));
    for (int item = gtid; item < MTOK * 8; item += nthreads) {
        const int tok = item >> 3, i = item & 7;
        const double ang = (double)positions[tok] * exp(-13.122363377404328 * (double)i / 8.0);
        ROPE[(size_t)tok * 16 + i] = (float)cos(ang); ROPE[(size_t)tok * 16 + 8 + i] = (float)sin(ang);
    }
}
constexpr int AT_KP = 144, AT_VP = 528;
constexpr int AT_K_OFF = 0, AT_V_OFF = 256 * AT_KP, AT_P_OFF = AT_V_OFF + 64 * AT_VP, AT_LDS = AT_P_OFF + 8 * 16 * AT_VP;
static_assert(AT_LDS <= 147456, "attention LDS");
typedef short bf16x8_t __attribute__((ext_vector_type(8)));
__device__ __forceinline__ void attn_phase(unsigned char* lds, int G, int cwg, const bf16* __restrict__ QO, const bf16* __restrict__ KO, const bf16* __restrict__ VTG, const bf16* __restrict__ ZO,
                                           const float* __restrict__ sinks, bf16* __restrict__ ABUF, int wv0) {
    int tid_ = tidx(wv0); asm volatile("" : "+v"(tid_));
    const int tid = tid_, lane = tid & 63, wv = __builtin_amdgcn_readfirstlane(tid >> 6), l15 = lane & 15, kg = lane >> 4;
    unsigned char* Ks = lds + AT_K_OFF; unsigned char* Vs = lds + AT_V_OFF; unsigned char* Ps = lds + AT_P_OFF + wv * 16 * AT_VP;
    u32x4 kreg[4], vreg[4];
    auto load_kv = [&](int U) {
        const int kvh = U & 3, j = (U >> 2) & 31, b = U >> 7; const size_t tok0 = (size_t)b * SEQ + 128 * j;
#pragma unroll
        for (int i = 0; i < 4; ++i) { const int p = tid + 512 * i, key = p >> 3, part = p & 7;
            kreg[i] = (u32x4){0u, 0u, 0u, 0u};
            if (j > 0 || key >= 128) kreg[i] = *(const u32x4*)(KO + (tok0 - 128 + key) * 256 + kvh * 64 + part * 8); }
#pragma unroll
        for (int i = 0; i < 4; ++i) { const int p = tid + 512 * i, dv = p >> 5, part = p & 31;
            vreg[i] = (u32x4){0u, 0u, 0u, 0u};
            if (j > 0 || part >= 16) vreg[i] = *(const u32x4*)(VTG + (size_t)(kvh * 64 + dv) * MTOK + tok0 - 128 + part * 8); }
    };
    bf16x8_t qn[4][2];
    auto load_q = [&](int U) {
        const int kvh = U & 3, j = (U >> 2) & 31, b = U >> 7; const size_t tok0 = (size_t)b * SEQ + 128 * j; const int head = kvh * 4 + (wv >> 1);
#pragma unroll
        for (int rb = 0; rb < 4; ++rb) { const bf16* qp = QO + (tok0 + (wv & 1) * 64 + rb * 16 + l15) * 1024 + head * 64 + kg * 8; qn[rb][0] = *(const bf16x8_t*)qp; qn[rb][1] = *(const bf16x8_t*)(qp + 32); }
    };
    if (cwg < NB * 32 * 4) { load_kv(cwg); load_q(cwg); }
    for (int U = cwg; U < NB * 32 * 4; U += G) {
        const int kvh = U & 3, j = (U >> 2) & 31, b = U >> 7;
        const size_t tok0 = (size_t)b * SEQ + 128 * j;
        const int head = kvh * 4 + (wv >> 1);
        bf16x8_t qf[4][2];
#pragma unroll
        for (int rb = 0; rb < 4; ++rb) { qf[rb][0] = qn[rb][0]; qf[rb][1] = qn[rb][1]; }
        __syncthreads();
#pragma unroll
        for (int i = 0; i < 4; ++i) { const int p = tid + 512 * i, key = p >> 3, part = p & 7; *(u32x4*)(Ks + key * AT_KP + part * 16) = kreg[i]; }
#pragma unroll
        for (int i = 0; i < 4; ++i) { const int p = tid + 512 * i, dv = p >> 5, part = p & 31; *(u32x4*)(Vs + dv * AT_VP + part * 16) = vreg[i]; }
        __syncthreads();
        if (U + G < NB * 32 * 4) { load_kv(U + G); load_q(U + G); }
        const float sink = sinks[head];
#pragma unroll
        for (int rb = 0; rb < 4; ++rb) {
            const int qb16 = (wv & 1) * 4 + rb, qoff = qb16 * 16;
            u32x2 zw[4];
#pragma unroll
            for (int db = 0; db < 4; ++db) zw[db] = *(const u32x2*)(ZO + (tok0 + qoff + l15) * 1024 + head * 64 + 4 * kg + db * 16);
            pg8::f32x4 s[9];
            float mx = sink;
#pragma unroll
            for (int kk = 0; kk < 9; ++kk) {
                const int kb = qb16 + kk; const bool have = (j > 0) || (kb >= 8);
                s[kk] = (pg8::f32x4){0.f, 0.f, 0.f, 0.f};
                if (have) {
                    const unsigned char* kp = Ks + (kb * 16 + l15) * AT_KP + kg * 16;
                    const bf16x8_t kf0 = *(const bf16x8_t*)kp, kf1 = *(const bf16x8_t*)(kp + 64);
                    s[kk] = __builtin_amdgcn_mfma_f32_16x16x32_bf16(kf0, qf[rb][0], s[kk], 0, 0, 0);
                    s[kk] = __builtin_amdgcn_mfma_f32_16x16x32_bf16(kf1, qf[rb][1], s[kk], 0, 0, 0);
                }
#pragma unroll
                for (int r = 0; r < 4; ++r) { const int ii = 4 * kg + r;
                    const bool ok = have && (kk == 0 ? (ii > l15) : (kk == 8 ? (ii <= l15) : true));
                    const float v = ok ? s[kk][r] * 0.125f : -INFINITY; s[kk][r] = v; mx = fmaxf(mx, v); }
            }
            mx = max_x32(max_x16(mx));
            float sum = 0.f;
            const int ks0 = qb16 >> 1, kbz = (qb16 & 1) ? (qb16 - 1) : (qb16 + 9);
            { unsigned z0 = 0u; asm volatile("" : "+v"(z0)); *(u32x2*)(Ps + l15 * AT_VP + (kbz * 16 + 4 * kg) * 2) = (u32x2){z0, z0}; }
#pragma unroll
            for (int kk = 0; kk < 9; ++kk) {
                float p[4];
#pragma unroll
                for (int r = 0; r < 4; ++r) { p[r] = __expf(s[kk][r] - mx); sum += p[r]; }
                u32x2 w; w.x = pk2(p[0], p[1]); w.y = pk2(p[2], p[3]);
                *(u32x2*)(Ps + l15 * AT_VP + ((qb16 + kk) * 16 + 4 * kg) * 2) = w;
            }
            sum = sum_x32(sum_x16(sum));
            const float inv = 1.f / (sum + __expf(sink - mx));
            asm volatile("s_waitcnt lgkmcnt(0)" ::: "memory");
            pg8::f32x4 o[4];
#pragma unroll
            for (int db = 0; db < 4; ++db) o[db] = (pg8::f32x4){0.f, 0.f, 0.f, 0.f};
#pragma unroll
            for (int k5 = 0; k5 < 5; ++k5) {
                const int ks = ks0 + k5;
                if (j > 0 || ks >= 4) {
                    const bf16x8_t pf = *(const bf16x8_t*)(Ps + l15 * AT_VP + (ks * 32 + kg * 8) * 2);
#pragma unroll
                    for (int db = 0; db < 4; ++db) { const bf16x8_t vf = *(const bf16x8_t*)(Vs + (db * 16 + l15) * AT_VP + (ks * 32 + kg * 8) * 2);
                        o[db] = __builtin_amdgcn_mfma_f32_16x16x32_bf16(vf, pf, o[db], 0, 0, 0); }
                }
            }
            const size_t orow = (tok0 + qoff + l15) * 1024 + head * 64 + 4 * kg;
#pragma unroll
            for (int db = 0; db < 4; ++db) {
                u32x2 w; w.x = pk2(o[db].x * inv * bflo(zw[db].x), o[db].y * inv * bfhi(zw[db].x)); w.y = pk2(o[db].z * inv * bflo(zw[db].y), o[db].w * inv * bfhi(zw[db].y));
                *(u32x2*)(ABUF + orow + db * 16) = w;
            }
            asm volatile("s_waitcnt lgkmcnt(0)" ::: "memory");
        }
    }
}
#define WB(T, ws, off) ((T*)((ws) + (unsigned)(off)))
#define WB2(T, ws, cst, off) ((T*)(((ws) + (size_t)(cst)) + (unsigned)(off)))
typedef unsigned char* wsp_t;

struct SchedGrid {
    const char* ws; unsigned a_off, b_off, a_pm, b_pn;
    int nM, nN, lda, ldb, K, pad;
    __device__ __forceinline__ bool at(int L, pg8::Unit& u) const {
        const int nwg = nM * nN; if (L >= nwg) return false;
        int wgid = L; { const int q = nwg / 8, r = nwg % 8, xcd = wgid % 8, off = wgid / 8; wgid = (xcd < r ? xcd * (q + 1) : r * (q + 1) + (xcd - r) * q) + off; }
        const int nig = 8 * nN, gid = wgid / nig, fm = gid * 8, gsz = (nM - fm) < 8 ? (nM - fm) : 8;
        u.pm = fm + ((wgid % nig) % gsz); u.pn = (wgid % nig) / gsz; u.z = 0; u.flags = pg8::UF_ZERO | pg8::UF_EPI; u.lda = lda; u.ldb = ldb; u.K = K; u.kind = 0;
        u.A = ws + (a_off + (unsigned)u.pm * a_pm); u.B = ws + (b_off + (unsigned)u.pn * b_pn); return true;
    }
};
struct FEvenIn2 {
    static constexpr int NV = 16;
    wsp_t ws;
    __device__ __forceinline__ void operator()(const pg8::Unit& u, int r, int c, f32x4 lo, f32x4 hi) const {
        const unsigned sec = u.pn >> 2, cs = (u.pn & 3) * 256 + c, rl = u.pm * 256 + r;
        if (sec & 1) { lo.x = silu_f(lo.x); lo.y = silu_f(lo.y); lo.z = silu_f(lo.z); lo.w = silu_f(lo.w); hi.x = silu_f(hi.x); hi.y = silu_f(hi.y); hi.z = silu_f(hi.z); hi.w = silu_f(hi.w); }
        u32x4 w; w.x = pk2(lo.x, lo.y); w.y = pk2(lo.z, lo.w); w.z = pk2(hi.x, hi.y); w.w = pk2(hi.z, hi.w);
        if (sec == 0) { const unsigned g = cs >> 4, q0 = cs & 15, bl = rl >> 12, t = rl & 4095;
            *WB2(u32x4, ws, w2::AU, ((g * S5ROWS + bl * 256 + (t >> 4)) * AUP + (t & 15) * 16 + q0) * 2) = w; }
        else *WB2(u32x4, ws, w2::ZS, (sec - 1) * (64u << 20) + (rl * 1024 + cs) * 2) = w;
    }
};
struct SchedS5 {
    const char* ws; unsigned b_off, b_g; int ldb, K;
    __device__ __forceinline__ bool at(int L, pg8::Unit& u) const {
        if (L >= 64 * 8) return false;
        u.z = L >> 3; u.pm = L & 7; u.pn = 0; u.flags = pg8::UF_ZERO | pg8::UF_EPI; u.lda = AUP; u.ldb = ldb; u.K = K; u.kind = 0;
        u.A = ws + (unsigned)(w2::AU + ((unsigned)u.z * S5ROWS + u.pm * 256) * AUP * 2); u.B = ws + (b_off + (unsigned)u.z * b_g); return true;
    }
};
struct FS5Z {
    static constexpr int NV = 0;
    wsp_t ws;
    __device__ __forceinline__ void operator()(const pg8::Unit& u, int r, int c, f32x4 lo, f32x4 hi) const {
        if (c < 128) { u32x4 w; w.x = pk2(lo.x, lo.y); w.y = pk2(lo.z, lo.w); w.z = pk2(hi.x, hi.y); w.w = pk2(hi.z, hi.w);
            *WB2(u32x4, ws, w2::ZINC, (((unsigned)u.z * S5ROWS + u.pm * 256 + r) * 128 + c) * 2) = w; }
    }
};
struct EpiS5Y {
    static constexpr int NV = 16;
    static constexpr bool PERM = true;
    wsp_t ws;
    __device__ __forceinline__ void mid(pg8::f32x4 (&)[2][2][4][2], const pg8::Unit&, int, int, int, int) const {}
    __device__ __forceinline__ void operator()(const pg8::f32x4 (&acc)[2][2][4][2], const pg8::Unit& u, int wr, int wc, int fr, int fq) const {
        const unsigned g = u.z;
#pragma unroll
        for (int ai = 0; ai < 2; ++ai)
#pragma unroll
            for (int m = 0; m < 4; ++m) {
                const unsigned row = (unsigned)u.pm * 256 + ai * 128 + wr * 64 + m * 16 + fr, bl = row >> 8, chunk = row & 255;
#pragma unroll
                for (int bj = 0; bj < 2; ++bj) {
                    const unsigned c = bj * 128 + wc * 32 + 8 * fq, j = c >> 4, p0 = c & 15;
                    const f32x4 lo = acc[ai][bj][m][0], hi = acc[ai][bj][m][1];
                    u32x4 w;
                    w.x = pk2(gelu_tanh_f(lo.x), gelu_tanh_f(lo.y)); w.y = pk2(gelu_tanh_f(lo.z), gelu_tanh_f(lo.w)); w.z = pk2(gelu_tanh_f(hi.x), gelu_tanh_f(hi.y)); w.w = pk2(gelu_tanh_f(hi.z), gelu_tanh_f(hi.w));
                    const unsigned tok = bl * SEQ + chunk * S5T + j;
                    *WB2(u32x4, ws, w2::Z, (tok * 1024 + g * 16 + p0) * 2) = w;
                }
            }
    }
};
struct EpiGlu {
    static constexpr int NV = 16;
    static constexpr bool PERM = true;
    wsp_t ws;
    __device__ __forceinline__ void mid(pg8::f32x4 (&)[2][2][4][2], const pg8::Unit&, int, int, int, int) const {}
    __device__ __forceinline__ void operator()(const pg8::f32x4 (&acc)[2][2][4][2], const pg8::Unit& u, int wr, int wc, int fr, int fq) const {
        u32x4 sg[2][4][2];
#pragma unroll
        for (int ai = 0; ai < 2; ++ai)
#pragma unroll
            for (int m = 0; m < 4; ++m)
#pragma unroll
                for (int bj = 0; bj < 2; ++bj) { const f32x4 lo = acc[ai][bj][m][0], hi = acc[ai][bj][m][1];
                    u32x4 w; w.x = pk2(sigmoid_f(lo.x), sigmoid_f(lo.y)); w.y = pk2(sigmoid_f(lo.z), sigmoid_f(lo.w)); w.z = pk2(sigmoid_f(hi.x), sigmoid_f(hi.y)); w.w = pk2(sigmoid_f(hi.z), sigmoid_f(hi.w)); sg[ai][m][bj] = w; }
        u32x4 yw[2][4][2], zw[2][4][2];
#pragma unroll
        for (int ai = 0; ai < 2; ++ai)
#pragma unroll
            for (int m = 0; m < 4; ++m)
#pragma unroll
                for (int bj = 0; bj < 2; ++bj) { const unsigned o = (((unsigned)u.pm * 256 + ai * 128 + wr * 64 + m * 16 + fr) * 1024 + u.pn * 256 + bj * 128 + wc * 32 + 8 * fq) * 2;
                    yw[ai][m][bj] = *WB2(const u32x4, ws, w2::Z, o); zw[ai][m][bj] = *WB2(const u32x4, ws, w2::ZS, o); }
        unsigned tie = 0u;
#pragma unroll
        for (int ai = 0; ai < 2; ++ai)
#pragma unroll
            for (int m = 0; m < 4; ++m)
#pragma unroll
                for (int bj = 0; bj < 2; ++bj) { const unsigned o = (((unsigned)u.pm * 256 + ai * 128 + wr * 64 + m * 16 + fr) * 1024 + u.pn * 256 + bj * 128 + wc * 32 + 8 * fq) * 2;
                    u32x4 y = yw[ai][m][bj], z = zw[ai][m][bj], g = sg[ai][m][bj]; asm volatile("" : "+v"(tie), "+v"(y.x), "+v"(z.x), "+v"(g.x));
                    u32x4 w;
                    w.x = pk2(bflo(y.x) * bflo(g.x) * bflo(z.x), bfhi(y.x) * bfhi(g.x) * bfhi(z.x));
                    w.y = pk2(bflo(y.y) * bflo(g.y) * bflo(z.y), bfhi(y.y) * bfhi(g.y) * bfhi(z.y));
                    w.z = pk2(bflo(y.z) * bflo(g.z) * bflo(z.z), bfhi(y.z) * bfhi(g.z) * bfhi(z.z));
                    w.w = pk2(bflo(y.w) * bflo(g.w) * bflo(z.w), bfhi(y.w) * bfhi(g.w) * bfhi(z.w));
                    *WB2(u32x4, ws, w2::AU, o) = w; tie = w.w; }
    }
};
struct EpiResidH {
    static constexpr int NV = 16;
    static constexpr bool PERM = true;
    const bf16* hsrc; void* dst; wsp_t ws; unsigned goff; int row0, dst_f32;
    __device__ __forceinline__ void mid(pg8::f32x4 (&)[2][2][4][2], const pg8::Unit&, int, int, int, int) const {}
    __device__ __forceinline__ void operator()(const pg8::f32x4 (&acc)[2][2][4][2], const pg8::Unit& u, int wr, int wc, int fr, int fq) const {
        const unsigned b = ((unsigned)row0 + u.pm * 256) >> 12;
        f32x4 gt[2][2];
#pragma unroll
        for (int bj = 0; bj < 2; ++bj)
#pragma unroll
            for (int n = 0; n < 2; ++n) gt[bj][n] = *WB(const f32x4, ws, goff + (b * 3072 + u.pn * 256 + bj * 128 + wc * 32 + 8 * fq + 4 * n) * 4);
#pragma unroll
        for (int ai = 0; ai < 2; ++ai) {
            u32x4 hv[4][2];
#pragma unroll
            for (int m = 0; m < 4; ++m)
#pragma unroll
                for (int bj = 0; bj < 2; ++bj) hv[m][bj] = *(const u32x4*)(hsrc + (size_t)((unsigned)row0 + u.pm * 256 + ai * 128 + wr * 64 + m * 16 + fr) * 1024 + u.pn * 256 + bj * 128 + wc * 32 + 8 * fq);
            if (dst_f32) {
#pragma unroll
                for (int m = 0; m < 4; ++m)
#pragma unroll
                    for (int bj = 0; bj < 2; ++bj) {
                        const u32x4 w = hv[m][bj]; const f32x4 a0 = acc[ai][bj][m][0], a1 = acc[ai][bj][m][1], g0 = gt[bj][0], g1 = gt[bj][1];
                        f32x4 lo, hi;
                        lo.x = bflo(w.x) + g0.x * a0.x; lo.y = bfhi(w.x) + g0.y * a0.y; lo.z = bflo(w.y) + g0.z * a0.z; lo.w = bfhi(w.y) + g0.w * a0.w;
                        hi.x = bflo(w.z) + g1.x * a1.x; hi.y = bfhi(w.z) + g1.y * a1.y; hi.z = bflo(w.w) + g1.z * a1.z; hi.w = bfhi(w.w) + g1.w * a1.w;
                        float* o = (float*)dst + (size_t)((unsigned)row0 + u.pm * 256 + ai * 128 + wr * 64 + m * 16 + fr) * 1024 + u.pn * 256 + bj * 128 + wc * 32 + 8 * fq;
                        *(f32x4*)o = lo; *(f32x4*)(o + 4) = hi;
                    }
            } else {
#pragma unroll
                for (int m = 0; m < 4; ++m)
#pragma unroll
                    for (int bj = 0; bj < 2; ++bj) {
                        const u32x4 w = hv[m][bj]; const f32x4 a0 = acc[ai][bj][m][0], a1 = acc[ai][bj][m][1], g0 = gt[bj][0], g1 = gt[bj][1];
                        u32x4 r;
                        r.x = pk2(bflo(w.x) + g0.x * a0.x, bfhi(w.x) + g0.y * a0.y); r.y = pk2(bflo(w.y) + g0.z * a0.z, bfhi(w.y) + g0.w * a0.w);
                        r.z = pk2(bflo(w.z) + g1.x * a1.x, bfhi(w.z) + g1.y * a1.y); r.w = pk2(bflo(w.w) + g1.z * a1.z, bfhi(w.w) + g1.w * a1.w);
                        *(u32x4*)((bf16*)dst + (size_t)((unsigned)row0 + u.pm * 256 + ai * 128 + wr * 64 + m * 16 + fr) * 1024 + u.pn * 256 + bj * 128 + wc * 32 + 8 * fq) = r;
                    }
            }
        }
    }
};
struct SchedQKO {
    const char* ws; unsigned w_off;
    __device__ __forceinline__ bool at(int L, pg8::Unit& u) const {
        if (L >= 2 * NUNIT) return false;
        const int t = L >> 3, j = L & 7, z = (j >> 2) * 2; u.z = z; u.pm = t; u.pn = j & 3; u.flags = pg8::UF_ZERO | pg8::UF_EPI; u.lda = 1024; u.ldb = 256; u.K = 256; u.kind = 0;
        u.A = ws + (unsigned)((z == 2 ? w2::MIN : w2::XC) + ((unsigned)u.pm * 256 * 1024 + u.pn * 256) * 2); u.B = ws + (w_off + ((unsigned)((z * (z + 1)) >> 1) << 20) + (unsigned)u.pn * 65536 * 2); return true;
    }
};
struct FQKO {
    static constexpr int NV = 0;
    wsp_t ws;
    __device__ __forceinline__ void operator()(const pg8::Unit& u, int r, int c, f32x4 lo, f32x4 hi) const {
        if (u.z == 2) { lo.x = sigmoid_f(lo.x); lo.y = sigmoid_f(lo.y); lo.z = sigmoid_f(lo.z); lo.w = sigmoid_f(lo.w); hi.x = sigmoid_f(hi.x); hi.y = sigmoid_f(hi.y); hi.z = sigmoid_f(hi.z); hi.w = sigmoid_f(hi.w); }
        u32x4 w; w.x = pk2(lo.x, lo.y); w.y = pk2(lo.z, lo.w); w.z = pk2(hi.x, hi.y); w.w = pk2(hi.z, hi.w);
        *WB2(u32x4, ws, w2::Q, (unsigned)u.z * (64u << 20) + (((unsigned)u.pm * 256 + r) * 1024 + u.pn * 256 + c) * 2) = w;
    }
};
struct EpiXO {
    static constexpr int NV = 0;
    static constexpr bool PERM = true;
    pg8::Epi8<FQKO> base; PG8_LAS float* qnp;
    __device__ __forceinline__ void mid(pg8::f32x4 (&)[2][2][4][2], const pg8::Unit&, int, int, int, int) const {}
    __device__ __forceinline__ void operator()(const pg8::f32x4 (&acc)[2][2][4][2], const pg8::Unit& u, int wr, int wc, int fr, int fq) const {
        base(acc, u, wr, wc, fr, fq);
        if (u.z == 0) {
            f32x4 nv[2][2];
#pragma unroll
            for (int bj = 0; bj < 2; ++bj)
#pragma unroll
                for (int n = 0; n < 2; ++n) nv[bj][n] = *WB2(const f32x4, base.f.ws, w2::NST, ((((unsigned)u.pm << 2) + u.pn) * 256 + bj * 128 + wc * 32 + 8 * fq + 4 * n) * 4);
#pragma unroll
            for (int ai = 0; ai < 2; ++ai)
#pragma unroll
                for (int m = 0; m < 4; ++m) {
                    const unsigned r = ai * 128 + wr * 64 + m * 16 + fr; float ps = 0.f;
#pragma unroll
                    for (int bj = 0; bj < 2; ++bj) {
                        const f32x4 lo = acc[ai][bj][m][0], hi = acc[ai][bj][m][1];
                        ps += ((lo.x * nv[bj][0].x + lo.y * nv[bj][0].y) + (lo.z * nv[bj][0].z + lo.w * nv[bj][0].w)) + ((hi.x * nv[bj][1].x + hi.y * nv[bj][1].y) + (hi.z * nv[bj][1].z + hi.w * nv[bj][1].w));
                    }
                    ps = sum_x32(sum_x16(ps));
                    if (fq == 0) qnp[((unsigned)u.kind * 256 + r) * 4 + wc] = ps;
                }
        }
    }
};
struct SchedKV {
    const char* ws; unsigned w_off;
    __device__ __forceinline__ bool at(int L, pg8::Unit& u) const {
        if (L >= 2 * NUNIT) return false;
        const int t = L >> 3, j = L & 7, z = j >> 2; u.z = z; u.pn = t; u.pm = j & 3; u.flags = pg8::UF_ZERO | pg8::UF_EPI; u.lda = 256; u.ldb = 1024; u.K = 256; u.kind = 0;
        u.A = ws + (w_off + ((unsigned)z << 20) + (unsigned)u.pm * 65536 * 2); u.B = ws + (unsigned)((z == 0 ? w2::XC : w2::MIN) + ((unsigned)u.pn * 256 * 1024 + u.pm * 256) * 2); return true;
    }
};
struct SchedProj {
    SchedKV s1; int G, c, pair;
    static __device__ __forceinline__ int kv_index(int Lp, int pair) {
        if (!pair) return Lp;
        const int j = Lp >> 8, p = (j >> 1) * 256 + (Lp & 255); return 8 * (p >> 2) + 4 * (j & 1) + (p & 3);
    }
    __device__ __forceinline__ bool next(int i, pg8::Unit& u) const { const int L = i * G + c; if (L >= 2 * NUNIT) return false; return s1.at(kv_index(L, pair), u); }
};
struct SchedQO {
    SchedQKO s0; int G, c;
    __device__ __forceinline__ bool next(int i, pg8::Unit& u) const { const int U = (i >> 1) * G + c; if (U >= NUNIT) return false; const bool ok = s0.at(8 * (U >> 2) + 4 * (i & 1) + (U & 3), u); u.kind = i >> 1; return ok; }
};
struct EpiKV {
    static constexpr int NV = 0;
    static constexpr bool PERM = true;
    wsp_t ws;
    __device__ __forceinline__ void mid(pg8::f32x4 (&)[2][2][4][2], const pg8::Unit&, int, int, int, int) const {}
    __device__ __forceinline__ void operator()(const pg8::f32x4 (&acc)[2][2][4][2], const pg8::Unit& u, int wr, int wc, int fr, int fq) const {
        const unsigned h = u.pm, dbase = w2::KWT + (unsigned)u.z * (64u << 20);
        f32x4 wx[2][2];
#pragma unroll
        for (int bj = 0; bj < 2; ++bj)
#pragma unroll
            for (int n = 0; n < 2; ++n) wx[bj][n] = (u.z == 0) ? *WB2(const f32x4, ws, w2::WEXP, (h * MH + (unsigned)u.pn * 256 + bj * 128 + wc * 32 + 8 * fq + 4 * n) * 4) : (f32x4){1.f, 1.f, 1.f, 1.f};
#pragma unroll
        for (int ai = 0; ai < 2; ++ai)
#pragma unroll
            for (int m = 0; m < 4; ++m) {
                const unsigned r = ai * 128 + wr * 64 + m * 16 + fr; float psum = 0.f;
#pragma unroll
                for (int bj = 0; bj < 2; ++bj) {
                    const unsigned c = bj * 128 + wc * 32 + 8 * fq;
                    const f32x4 lo = acc[ai][bj][m][0] * wx[bj][0], hi = acc[ai][bj][m][1] * wx[bj][1];
                    psum += ((lo.x + lo.y) + (lo.z + lo.w)) + ((hi.x + hi.y) + (hi.z + hi.w));
                    u32x4 w; w.x = pk2(lo.x, lo.y); w.y = pk2(lo.z, lo.w); w.z = pk2(hi.x, hi.y); w.w = pk2(hi.z, hi.w);
                    *WB(u32x4, ws, dbase + ((((unsigned)u.pn * 1024 + h * 256 + r) * 256) + c) * 2) = w;
                }
                if (u.z == 0) { psum = sum_x32(sum_x16(psum)); if (fq == 0) *WB2(float, ws, w2::DNP, ((((unsigned)u.pn * 4 + h) * 4 + wc) * 256 + r) * 4) = psum; }
            }
    }
};
struct SchedDC {
    const char* ws;
    __device__ __forceinline__ bool at(int U, pg8::Unit& u) const {
        if (U >= NUNIT) return false;
        u.pn = U >> 2; u.pm = U & 3; u.z = 0; u.flags = pg8::UF_ZERO | pg8::UF_EPI; u.lda = 256; u.ldb = 256; u.K = 256; u.kind = 0;
        const unsigned off = (((unsigned)u.pn * 1024 + u.pm * 256) * 256) * 2; u.A = ws + (unsigned)(w2::VT + off); u.B = ws + (unsigned)(w2::KWT + off); return true;
    }
};
struct FDC {
    static constexpr int NV = 16;
    wsp_t ws;
    __device__ __forceinline__ void operator()(const pg8::Unit& u, int r, int c, f32x4 lo, f32x4 hi) const {
        u32x4 w; w.x = pk2(lo.x, lo.y); w.y = pk2(lo.z, lo.w); w.z = pk2(hi.x, hi.y); w.w = pk2(hi.z, hi.w);
        *WB2(u32x4, ws, w2::CT, ((((unsigned)u.pn * 1024 + u.pm * 256 + r) * 256) + c) * 2) = w;
    }
};
struct SchedS {
    const char* ws;
    __device__ __forceinline__ bool at(int U, pg8::Unit& u) const {
        if (U >= NUNIT) return false;
        u.pn = U >> 2; u.pm = U & 3; u.z = 0; u.flags = pg8::UF_ZERO | pg8::UF_EPI; u.lda = 1024; u.ldb = 1024; u.K = 256; u.kind = 0;
        const unsigned off = ((unsigned)u.pn * 256 * 1024 + u.pm * 256) * 2; u.A = ws + (unsigned)(w2::Q + off); u.B = ws + (unsigned)(w2::XC + off); return true;
    }
};
struct EpiS {
    static constexpr int NV = 0;
    static constexpr bool PERM = true;
    wsp_t ws;
    __device__ __forceinline__ void mid(pg8::f32x4 (&)[2][2][4][2], const pg8::Unit&, int, int, int, int) const {}
    __device__ __forceinline__ void operator()(const pg8::f32x4 (&acc)[2][2][4][2], const pg8::Unit& u, int wr, int wc, int fr, int fq) const {
        const unsigned h = u.pm;
        f32x4 kp[2][2]; float pmv[2][4];
#pragma unroll
        for (int bj = 0; bj < 2; ++bj)
#pragma unroll
            for (int n = 0; n < 2; ++n) kp[bj][n] = *WB2(const f32x4, ws, w2::KAP, (h * MH + (unsigned)u.pn * 256 + bj * 128 + wc * 32 + 8 * fq + 4 * n) * 4);
#pragma unroll
        for (int ai = 0; ai < 2; ++ai)
#pragma unroll
            for (int m = 0; m < 4; ++m) pmv[ai][m] = *WB2(const float, ws, w2::PMX, (h * MH + (unsigned)u.pn * 256 + ai * 128 + wr * 64 + m * 16 + fr) * 4);
        const float mc = mlstm_mc(WB2(const float, ws, w2::BT, 0), WB2(const float, ws, w2::MLOC, 0), u.pn, h);
#pragma unroll
        for (int ai = 0; ai < 2; ++ai)
#pragma unroll
            for (int m = 0; m < 4; ++m) {
                const unsigned r = ai * 128 + wr * 64 + m * 16 + fr, tokj = (unsigned)u.pn * 256 + r;
                const float rho = fmaxf(mc, pmv[ai][m]); float psum = 0.f;
#pragma unroll
                for (int bj = 0; bj < 2; ++bj) {
                    const unsigned c = bj * 128 + wc * 32 + 8 * fq;
                    const f32x4 k0 = kp[bj][0], k1 = kp[bj][1];
                    const f32x4 lo = acc[ai][bj][m][0], hi = acc[ai][bj][m][1];
                    float p[8];
                    p[0] = (c + 0 <= r) ? lo.x * __expf(k0.x - rho) : 0.f; p[1] = (c + 1 <= r) ? lo.y * __expf(k0.y - rho) : 0.f;
                    p[2] = (c + 2 <= r) ? lo.z * __expf(k0.z - rho) : 0.f; p[3] = (c + 3 <= r) ? lo.w * __expf(k0.w - rho) : 0.f;
                    p[4] = (c + 4 <= r) ? hi.x * __expf(k1.x - rho) : 0.f; p[5] = (c + 5 <= r) ? hi.y * __expf(k1.y - rho) : 0.f;
                    p[6] = (c + 6 <= r) ? hi.z * __expf(k1.z - rho) : 0.f; p[7] = (c + 7 <= r) ? hi.w * __expf(k1.w - rho) : 0.f;
                    psum += ((p[0] + p[1]) + (p[2] + p[3])) + ((p[4] + p[5]) + (p[6] + p[7]));
                    u32x4 w; w.x = pk2(p[0], p[1]); w.y = pk2(p[2], p[3]); w.z = pk2(p[4], p[5]); w.w = pk2(p[6], p[7]);
                    *WB2(u32x4, ws, w2::MIN, (tokj * 1024 + h * 256 + c) * 2) = w;
                }
                psum = sum_x32(sum_x16(psum));
                if (fq == 0) *WB2(float, ws, w2::DSP, ((tokj * 4 + h) * 4 + wc) * 4) = psum;
            }
    }
};
struct SchedQP {
    const char* ws; int G, c;
    __device__ __forceinline__ bool next(int i, pg8::Unit& u) const {
        const int ui = i >> 1, seg = i & 1, U = ui * G + c; if (U >= NUNIT) return false;
        u.pn = U >> 2; u.pm = U & 3; u.z = ui; u.lda = 1024; u.ldb = 256; u.K = 256; u.kind = 0;
        const unsigned ao = ((unsigned)u.pn * 256 * 1024 + u.pm * 256) * 2, bo = (((unsigned)u.pn * 1024 + u.pm * 256) * 256) * 2;
        u.A = ws + (unsigned)((seg ? w2::MIN : w2::Q) + ao); u.B = ws + (unsigned)((seg ? w2::VT : w2::CT) + bo); u.flags = seg ? pg8::UF_EPI : (pg8::UF_ZERO | pg8::UF_MID);
        return true;
    }
};
struct EpiQP {
    static constexpr int NV = 0;
    static constexpr bool PERM = true;
    wsp_t ws; const float* ng; const float* skip; PG8_LAS float* qn; PG8_LAS float* xs;
    __device__ __forceinline__ void mid(pg8::f32x4 (&acc)[2][2][4][2], const pg8::Unit& u, int wr, int wc, int fr, int fq) const {
        const unsigned h = u.pm; float pmv[2][4];
#pragma unroll
        for (int ai = 0; ai < 2; ++ai)
#pragma unroll
            for (int m = 0; m < 4; ++m) pmv[ai][m] = *WB2(const float, ws, w2::PMX, (h * MH + (unsigned)u.pn * 256 + ai * 128 + wr * 64 + m * 16 + fr) * 4);
        const float mc = mlstm_mc(WB2(const float, ws, w2::BT, 0), WB2(const float, ws, w2::MLOC, 0), u.pn, h);
        if (fr + fq == 0) qn[2048 + wr * 4 + wc] = mc;
#pragma unroll
        for (int ai = 0; ai < 2; ++ai)
#pragma unroll
            for (int m = 0; m < 4; ++m) {
                const float g = __expf(mc - fmaxf(mc, pmv[ai][m]));
#pragma unroll
                for (int bj = 0; bj < 2; ++bj) { acc[ai][bj][m][0] = acc[ai][bj][m][0] * g; acc[ai][bj][m][1] = acc[ai][bj][m][1] * g; }
            }
    }
    __device__ __forceinline__ void operator()(pg8::f32x4 (&acc)[2][2][4][2], const pg8::Unit& u, int wr, int wc, int fr, int fq) const {
        const unsigned h = u.pm; const float mc = qn[2048 + wr * 4 + wc];
#pragma unroll
        for (int ai = 0; ai < 2; ++ai)
#pragma unroll
        for (int mh = 0; mh < 4; mh += 2) {
            float pmv[4], bcv[4]; f32x4 dsv[4]; u32x4 owv[4][2];
#pragma unroll
            for (int m = mh; m < mh + 2; ++m) { const unsigned tokj = (unsigned)u.pn * 256 + ai * 128 + wr * 64 + m * 16 + fr;
                pmv[m] = *WB2(const float, ws, w2::PMX, (h * MH + tokj) * 4); bcv[m] = *WB2(const float, ws, w2::BCUM, (h * MH + tokj) * 4); dsv[m] = *WB2(const f32x4, ws, w2::DSP, ((tokj * 4 + h) * 4) * 4);
#pragma unroll
                for (int bj = 0; bj < 2; ++bj) owv[m][bj] = *WB2(const u32x4, ws, w2::O, (tokj * 1024 + h * 256 + bj * 128 + wc * 32 + 8 * fq) * 2); }
#pragma unroll
            for (int m = mh; m < mh + 2; ++m) {
                const unsigned r = ai * 128 + wr * 64 + m * 16 + fr;
                const float rho = fmaxf(mc, pmv[m]), g = __expf(mc - rho);
                const f32x4 qn4 = *(const PG8_LAS f32x4*)(qn + (u.z * 256 + r) * 4);
                const float den = ((dsv[m].x + dsv[m].y) + (dsv[m].z + dsv[m].w)) + g * ((qn4.x + qn4.y) + (qn4.z + qn4.w));
                const float inv = 1.f / fmaxf(fabsf(den), __expf(-(bcv[m] + rho)));
                float ss = 0.f;
#pragma unroll
                for (int bj = 0; bj < 2; ++bj) {
                    const u32x4 ow = owv[m][bj];
                    f32x4 lo = acc[ai][bj][m][0] * inv, hi = acc[ai][bj][m][1] * inv;
                    lo.x *= bflo(ow.x); lo.y *= bfhi(ow.x); lo.z *= bflo(ow.y); lo.w *= bfhi(ow.y); hi.x *= bflo(ow.z); hi.y *= bfhi(ow.z); hi.z *= bflo(ow.w); hi.w *= bfhi(ow.w);
                    ss += ((lo.x * lo.x + lo.y * lo.y) + (lo.z * lo.z + lo.w * lo.w)) + ((hi.x * hi.x + hi.y * hi.y) + (hi.z * hi.z + hi.w * hi.w));
                    acc[ai][bj][m][0] = lo; acc[ai][bj][m][1] = hi;
                }
                ss = sum_x32(sum_x16(ss));
                if (fq == 0) xs[r * 4 + wc] = ss;
            }
        }
        asm volatile("s_waitcnt lgkmcnt(0)" ::: "memory"); __builtin_amdgcn_s_barrier(); asm volatile("" ::: "memory");
        f32x4 gv[2][2], sv[2][2];
#pragma unroll
        for (int bj = 0; bj < 2; ++bj)
#pragma unroll
            for (int n = 0; n < 2; ++n) { const unsigned hc = h * 256 + bj * 128 + wc * 32 + 8 * fq + 4 * n; gv[bj][n] = *(const f32x4*)(ng + hc); sv[bj][n] = *(const f32x4*)(skip + hc); }
#pragma unroll
        for (int ai = 0; ai < 2; ++ai)
#pragma unroll
        for (int mh = 0; mh < 4; mh += 2) {
            u32x4 xwv[4][2], zwv[4][2]; f32x4 x4v[4];
#pragma unroll
            for (int m = mh; m < mh + 2; ++m) { const unsigned r = ai * 128 + wr * 64 + m * 16 + fr, tokj = (unsigned)u.pn * 256 + r;
                x4v[m] = *(const PG8_LAS f32x4*)(xs + r * 4);
#pragma unroll
                for (int bj = 0; bj < 2; ++bj) { const unsigned o = (tokj * 1024 + h * 256 + bj * 128 + wc * 32 + 8 * fq) * 2; xwv[m][bj] = *WB2(const u32x4, ws, w2::XC, o); zwv[m][bj] = *WB2(const u32x4, ws, w2::MZS, o); } }
#pragma unroll
            for (int m = mh; m < mh + 2; ++m) {
                const unsigned r = ai * 128 + wr * 64 + m * 16 + fr, tokj = (unsigned)u.pn * 256 + r;
                const float rstd = rsqrtf(((x4v[m].x + x4v[m].y) + (x4v[m].z + x4v[m].w)) * (1.f / 256.f) + EPS);
#pragma unroll
                for (int bj = 0; bj < 2; ++bj) {
                    const unsigned hc = h * 256 + bj * 128 + wc * 32 + 8 * fq;
                    const u32x4 xw = xwv[m][bj], zw = zwv[m][bj]; const f32x4 g0 = gv[bj][0], g1 = gv[bj][1], s0 = sv[bj][0], s1 = sv[bj][1];
                    const f32x4 lo = acc[ai][bj][m][0], hi = acc[ai][bj][m][1];
                    u32x4 w;
                    w.x = pk2((lo.x * rstd * g0.x + s0.x * bflo(xw.x)) * bflo(zw.x), (lo.y * rstd * g0.y + s0.y * bfhi(xw.x)) * bfhi(zw.x));
                    w.y = pk2((lo.z * rstd * g0.z + s0.z * bflo(xw.y)) * bflo(zw.y), (lo.w * rstd * g0.w + s0.w * bfhi(xw.y)) * bfhi(zw.y));
                    w.z = pk2((hi.x * rstd * g1.x + s1.x * bflo(xw.z)) * bflo(zw.z), (hi.y * rstd * g1.y + s1.y * bfhi(xw.z)) * bfhi(zw.z));
                    w.w = pk2((hi.z * rstd * g1.z + s1.z * bflo(xw.w)) * bflo(zw.w), (hi.w * rstd * g1.w + s1.w * bfhi(xw.w)) * bfhi(zw.w));
                    *WB2(u32x4, ws, w2::KWT, (tokj * 1024 + hc) * 2) = w;
                }
            }
        }
    }
};
struct SchedOut2 {
    const char* ws; unsigned b_off; int G, c;
    __device__ __forceinline__ bool next(int i, pg8::Unit& u) const {
        const int ui = i >> 1, seg = i & 1; const int nM = NTILE, nN = 4, nwg = nM * nN; const int L = ui * G + c; if (L >= nwg) return false;
        int wgid = L; { const int q = nwg / 8, r = nwg % 8, xcd = wgid % 8, off = wgid / 8; wgid = (xcd < r ? xcd * (q + 1) : r * (q + 1) + (xcd - r) * q) + off; }
        const int nig = 8 * nN, gid = wgid / nig, fm = gid * 8, gsz = (nM - fm) < 8 ? (nM - fm) : 8;
        u.pm = fm + ((wgid % nig) % gsz); u.pn = (wgid % nig) / gsz; u.z = 0; u.flags = seg ? pg8::UF_EPI : pg8::UF_ZERO; u.lda = 1024; u.ldb = 2048; u.K = 1024; u.kind = 0;
        u.A = ws + (unsigned)((seg ? w2::KWT : w2::AU) + (unsigned)u.pm * 256 * 1024 * 2); u.B = ws + (b_off + ((unsigned)u.pn * 256 * 2048 + seg * 1024) * 2); return true;
    }
};
struct SchedOddIn {
    SchedGrid g;
    __device__ __forceinline__ bool at(int L, pg8::Unit& u) const {
        if (!g.at(L, u)) return false;
        if (u.pn == 5) { const char* t = u.A; u.A = u.B; u.B = t; }
        return true;
    }
};
struct EpiOddIn {
    static constexpr int NV = 0;
    static constexpr bool PERM = true;
    wsp_t ws; const float* qg; const float* kg;
    __device__ __forceinline__ void mid(pg8::f32x4 (&)[2][2][4][2], const pg8::Unit&, int, int, int, int) const {}
    __device__ __forceinline__ void operator()(const pg8::f32x4 (&acc)[2][2][4][2], const pg8::Unit& u, int wr, int wc, int fr, int fq) const {
        const int pn = u.pn;
#pragma unroll
        for (int ai = 0; ai < 2; ++ai)
#pragma unroll
            for (int m = 0; m < 4; ++m) {
                const unsigned r = ai * 128 + wr * 64 + m * 16 + fr, tok = (unsigned)u.pm * 256 + r;
                if (pn < 5) {
                    f32x4 v[2][2]; float ss = 0.f;
#pragma unroll
                    for (int bj = 0; bj < 2; ++bj)
#pragma unroll
                        for (int n = 0; n < 2; ++n) { v[bj][n] = acc[ai][bj][m][n]; ss += (v[bj][n].x * v[bj][n].x + v[bj][n].y * v[bj][n].y) + (v[bj][n].z * v[bj][n].z + v[bj][n].w * v[bj][n].w); }
                    ss = sum_x32(sum_x16(ss));
                    const float rstd = rsqrtf(ss * (1.f / 64.f) + EPS);
                    const float* gp = (pn < 4) ? qg : kg;
#pragma unroll
                    for (int bj = 0; bj < 2; ++bj)
#pragma unroll
                        for (int n = 0; n < 2; ++n) v[bj][n] = v[bj][n] * rstd * *(const f32x4*)(gp + 32 * bj + 8 * fq + 4 * n);
                    f32x4 p0, p1;
                    const int ln_ = fq << 4; p0.x = other_x16(v[0][0].x, ln_); p0.y = other_x16(v[0][0].y, ln_); p0.z = other_x16(v[0][0].z, ln_); p0.w = other_x16(v[0][0].w, ln_);
                    p1.x = other_x16(v[0][1].x, ln_); p1.y = other_x16(v[0][1].y, ln_); p1.z = other_x16(v[0][1].z, ln_); p1.w = other_x16(v[0][1].w, ln_);
                    if (fq < 2) {
                        const f32x4 c0 = *WB2(const f32x4, ws, w2::ROPE, tok * 64), c1 = *WB2(const f32x4, ws, w2::ROPE, tok * 64 + 16), s0 = *WB2(const f32x4, ws, w2::ROPE, tok * 64 + 32), s1 = *WB2(const f32x4, ws, w2::ROPE, tok * 64 + 48);
                        const float sg = (fq == 0) ? -1.f : 1.f;
                        v[0][0] = v[0][0] * c0 + p0 * s0 * sg; v[0][1] = v[0][1] * c1 + p1 * s1 * sg;
                    }
#pragma unroll
                    for (int bj = 0; bj < 2; ++bj) {
                        u32x4 w; w.x = pk2(v[bj][0].x, v[bj][0].y); w.y = pk2(v[bj][0].z, v[bj][0].w); w.z = pk2(v[bj][1].x, v[bj][1].y); w.w = pk2(v[bj][1].z, v[bj][1].w);
                        const unsigned d = 32 * bj + 8 * fq;
                        if (pn < 4) *WB2(u32x4, ws, w2::QO, (tok * 1024 + (pn * 4 + wc) * 64 + d) * 2) = w; else *WB2(u32x4, ws, w2::KO, (tok * 256 + wc * 64 + d) * 2) = w;
                    }
                } else if (pn == 5) {
#pragma unroll
                    for (int bj = 0; bj < 2; ++bj) {
                        const unsigned c = bj * 128 + wc * 32 + 8 * fq; const f32x4 lo = acc[ai][bj][m][0], hi = acc[ai][bj][m][1];
                        u32x4 w; w.x = pk2(lo.x, lo.y); w.y = pk2(lo.z, lo.w); w.z = pk2(hi.x, hi.y); w.w = pk2(hi.z, hi.w);
                        *WB2(u32x4, ws, w2::VTG, (r * MTOK + (unsigned)u.pm * 256 + c) * 2) = w;
                    }
                } else {
#pragma unroll
                    for (int bj = 0; bj < 2; ++bj) {
                        const unsigned c = (pn - 6) * 256 + bj * 128 + wc * 32 + 8 * fq; const f32x4 lo = acc[ai][bj][m][0], hi = acc[ai][bj][m][1];
                        u32x4 w; w.x = pk2(silu_f(lo.x), silu_f(lo.y)); w.y = pk2(silu_f(lo.z), silu_f(lo.w)); w.z = pk2(silu_f(hi.x), silu_f(hi.y)); w.w = pk2(silu_f(hi.z), silu_f(hi.w));
                        *WB2(u32x4, ws, w2::ZO, (tok * 1024 + c) * 2) = w;
                    }
                }
            }
    }
};
#define LAS __attribute__((address_space(3)))
#define XB_TMO      128
#define XB_XCNT(j)  (256  + 64 * (j))
#define XB_XSUB(j)  (1280 + 64 * (j))
#define XB_XGEN(j)  (2304 + 64 * (j))
#define XB_TOP      3328
#define XB_TOPGEN   3392
#define XCD_BAR_WORDS 3456
#define XB_SPIN_CAP (1u << 22)
__device__ __forceinline__ unsigned xb_ld(unsigned* p)              { return __hip_atomic_load(p, __ATOMIC_RELAXED, __HIP_MEMORY_SCOPE_AGENT); }
__device__ __forceinline__ unsigned xb_add(unsigned* p, unsigned v) { return __hip_atomic_fetch_add(p, v, __ATOMIC_RELAXED, __HIP_MEMORY_SCOPE_AGENT); }
__device__ __forceinline__ unsigned xb_xcc_id() { return (unsigned)__builtin_amdgcn_s_getreg((3 << 11) | 20) & 0xFu; }
#define XB_SPIN(cond, bar) do { unsigned _sp = 0; while (cond) { __builtin_amdgcn_s_sleep(1); \
    if ((++_sp & 255u) == 0u) { if (xb_ld(&(bar)[XB_TMO])) break; if (_sp > XB_SPIN_CAP) { atomicAdd(&(bar)[XB_TMO], 1u); break; } } } } while (0)
struct XcdBarrier { unsigned* bar; unsigned x; volatile LAS unsigned* st; };
__device__ __forceinline__ XcdBarrier xcd_barrier_post(unsigned* bar, volatile LAS unsigned* st, int wv0) {
    XcdBarrier b; b.bar = bar; b.x = xb_xcc_id(); b.st = st;
    if (tidx(wv0) == 0) (void)xb_add(&bar[XB_XCNT(b.x)], 1u);
    return b;
}
__device__ __forceinline__ void xcd_barrier_complete(unsigned* bar, unsigned x, unsigned& nloc, unsigned& nx) {
    const unsigned G = gridDim.x * gridDim.y * gridDim.z;
    unsigned sum, cnt, sp = 0u;
    for (;;) {
        sum = 0u; cnt = 0u;
#pragma unroll 1
        for (unsigned j = 0; j < 16; ++j) { const unsigned c = xb_ld(&bar[XB_XCNT(j)]); sum += c; cnt += (c > 0u) ? 1u : 0u; }
        if (sum == G) break;
        __builtin_amdgcn_s_sleep(1);
        if ((++sp & 255u) == 0u) { if (xb_ld(&bar[XB_TMO])) break; if (sp > XB_SPIN_CAP) { atomicAdd(&bar[XB_TMO], 1u); break; } }
    }
    const unsigned mine = xb_ld(&bar[XB_XCNT(x)]);
    nloc = mine > 0u ? mine : 1u; nx = cnt > 0u ? cnt : 1u;
}
__device__ __forceinline__ void xcd_barrier(const XcdBarrier& b, int wv0) {
    asm volatile("s_waitcnt vmcnt(0)" ::: "memory");
    __syncthreads();
    if (tidx(wv0) == 0) {
        unsigned* bar = b.bar;
        __builtin_amdgcn_s_waitcnt(0);
        unsigned nloc = b.st[0], nx = b.st[1];
        if (nloc == 0u) { xcd_barrier_complete(bar, b.x, nloc, nx); b.st[0] = nloc; b.st[1] = nx; }
        const unsigned old = xb_add(&bar[XB_XSUB(b.x)], 1u);
        const unsigned gen = old / nloc;
        if (old + 1u == (gen + 1u) * nloc) {
            __builtin_amdgcn_fence(__ATOMIC_RELEASE, "agent");
            asm volatile("s_waitcnt vmcnt(0)" ::: "memory");
            const unsigned og = xb_add(&bar[XB_TOP], 1u);
            const unsigned tg = og / nx;
            if (og + 1u == (tg + 1u) * nx) xb_add(&bar[XB_TOPGEN], 1u);
            else XB_SPIN(xb_ld(&bar[XB_TOPGEN]) == tg, bar);
            __builtin_amdgcn_fence(__ATOMIC_ACQUIRE, "agent");
            asm volatile("s_waitcnt vmcnt(0)" ::: "memory");
        } else {
            XB_SPIN(xb_ld(&bar[XB_TOPGEN]) == gen, bar);
            __builtin_amdgcn_fence(__ATOMIC_ACQUIRE, "agent");
            asm volatile("s_waitcnt vmcnt(0)" ::: "memory");
        }
    }
    __syncthreads();
}

__device__ __forceinline__ void adaln_item(float* sm, int item, const float* __restrict__ c, const float* __restrict__ ada_w, const float* __restrict__ ada_b, float* __restrict__ mod, int wv0) {
    int tid_ = tidx(wv0); asm volatile("" : "+v"(tid_)); const int tid = tid_, lane = tid & 63, wv = tid >> 6, l = item / 48, cg = item % 48;
    float* part = sm + 16384;
    for (int i = tid; i < 16384; i += 512) { const float v = c[i]; sm[i] = v / (1.f + expf(-v)); }
    __syncthreads();
    float acc[16];
#pragma unroll
    for (int b = 0; b < 16; ++b) acc[b] = 0.f;
    const float* w = ada_w + ((size_t)l * 1024 + wv * 128) * 3072 + cg * 64 + lane;
#pragma unroll 16
    for (int k = 0; k < 128; ++k) { const float wvv = w[(size_t)k * 3072];
#pragma unroll
        for (int b = 0; b < 16; ++b) acc[b] += sm[b * 1024 + wv * 128 + k] * wvv; }
#pragma unroll
    for (int b = 0; b < 16; ++b) part[(wv * 16 + b) * 64 + lane] = acc[b];
    __syncthreads();
    for (int o = tid; o < 1024; o += 512) { const int b = o >> 6, ln = o & 63; float s = 0.f;
#pragma unroll
        for (int w8 = 0; w8 < 8; ++w8) s += part[(w8 * 16 + b) * 64 + ln];
        mod[(size_t)(l * 16 + b) * 3072 + cg * 64 + ln] = s + ada_b[l * 3072 + cg * 64 + ln]; }
    __syncthreads();
}
__device__ __forceinline__ void wt_tile(float* t  , const float* __restrict__ W, int K, int N, bf16* __restrict__ WT, int tile, float scale, bool perm, int wv0) {
    int tid_ = tidx(wv0); asm volatile("" : "+v"(tid_)); const int tiles_n = N / 64, tk = tile / tiles_n, tn = tile % tiles_n, tid = tid_;
#pragma unroll
    for (int r = 0; r < 8; ++r) { const int i = tid + 512 * r, kk = i >> 6, nn = i & 63; const int ncol = perm ? oddin_logical_col(tn * 64 + nn) : tn * 64 + nn;
        t[kk * 65 + nn] = W[(size_t)(tk * 64 + kk) * N + ncol]; }
    __syncthreads();
#pragma unroll
    for (int r = 0; r < 8; ++r) { const int i = tid + 512 * r, nn = i >> 6, kk = i & 63; WT[(size_t)(tn * 64 + nn) * K + tk * 64 + kk] = f2bf(t[kk * 65 + nn] * scale); }
    __syncthreads();
}
__device__ __forceinline__ float ssq8(u32x4 w) {
    const float a = bflo(w.x), b = bfhi(w.x), c = bflo(w.y), d = bfhi(w.y), e = bflo(w.z), f = bfhi(w.z), g = bflo(w.w), h = bfhi(w.w);
    return ((a * a + b * b) + (c * c + d * d)) + ((e * e + f * f) + (g * g + h * h));
}
__device__ __forceinline__ u32x4 norm8v(u32x4 w, float r, const float* gs, const float* sf) {
    u32x4 o;
    o.x = pk2(bflo(w.x) * r * gs[0] + sf[0], bfhi(w.x) * r * gs[1] + sf[1]); o.y = pk2(bflo(w.y) * r * gs[2] + sf[2], bfhi(w.y) * r * gs[3] + sf[3]);
    o.z = pk2(bflo(w.z) * r * gs[4] + sf[4], bfhi(w.z) * r * gs[5] + sf[5]); o.w = pk2(bflo(w.w) * r * gs[6] + sf[6], bfhi(w.w) * r * gs[7] + sf[7]);
    return o;
}
__device__ __forceinline__ void norm_rows_b(int gwave, int nwaves, int lane, const bf16* __restrict__ h, const float* __restrict__ g, const float* __restrict__ modl, bf16* __restrict__ hn, int row0, int nrows) {
    asm volatile("" : "+v"(lane));
    const int R = (nrows + nwaves - 1) / nwaves, ra0 = gwave * R, ra1 = min(ra0 + R, nrows);
    if (ra0 >= ra1) return;
    float gs[16], sf[16]; int cb = -1;
    u32x4 cur[4][2], nxt[4][2];
#pragma unroll
    for (int q = 0; q < 4; ++q) { const u32x4* x = (const u32x4*)(h + (size_t)(row0 + min(ra0 + q, ra1 - 1)) * DM) + lane; cur[q][0] = x[0]; cur[q][1] = x[64]; }
    for (int rl = ra0; rl < ra1; rl += 4) {
        auto load_mod = [&](int b) { cb = b; const float* sh = modl + (size_t)b * 3072;
#pragma unroll
            for (int q = 0; q < 2; ++q) { const int col = q * 512 + lane * 8;
                const f32x4 g0 = *(const f32x4*)(g + col), g1 = *(const f32x4*)(g + col + 4), c0 = *(const f32x4*)(sh + 1024 + col) + 1.0f, c1 = *(const f32x4*)(sh + 1028 + col) + 1.0f, s0 = *(const f32x4*)(sh + col), s1 = *(const f32x4*)(sh + col + 4);
                gs[q * 8 + 0] = g0.x * c0.x; gs[q * 8 + 1] = g0.y * c0.y; gs[q * 8 + 2] = g0.z * c0.z; gs[q * 8 + 3] = g0.w * c0.w; gs[q * 8 + 4] = g1.x * c1.x; gs[q * 8 + 5] = g1.y * c1.y; gs[q * 8 + 6] = g1.z * c1.z; gs[q * 8 + 7] = g1.w * c1.w;
                sf[q * 8 + 0] = s0.x; sf[q * 8 + 1] = s0.y; sf[q * 8 + 2] = s0.z; sf[q * 8 + 3] = s0.w; sf[q * 8 + 4] = s1.x; sf[q * 8 + 5] = s1.y; sf[q * 8 + 6] = s1.z; sf[q * 8 + 7] = s1.w; } };
        if (rl + 4 < ra1) {
#pragma unroll
            for (int q = 0; q < 4; ++q) { const u32x4* x = (const u32x4*)(h + (size_t)(row0 + min(rl + 4 + q, ra1 - 1)) * DM) + lane; nxt[q][0] = x[0]; nxt[q][1] = x[64]; }
        }
#pragma unroll
        for (int q = 0; q < 4; ++q) {
            const float r = rsqrtf(wave_sum(ssq8(cur[q][0]) + ssq8(cur[q][1])) * (1.f / DM) + EPS);
            if (rl + q < ra1) { const int bq = (row0 + rl + q) >> 12; if (bq != cb) load_mod(bq);
                u32x4* o = (u32x4*)(hn + (size_t)(rl + q) * DM) + lane; o[0] = norm8v(cur[q][0], r, gs, sf); o[64] = norm8v(cur[q][1], r, gs + 8, sf + 8); }
        }
#pragma unroll
        for (int q = 0; q < 4; ++q) { cur[q][0] = nxt[q][0]; cur[q][1] = nxt[q][1]; }
    }
}
__device__ __forceinline__ void norm_rows(int gwave, int nwaves, int lane, const float* __restrict__ h, const float* __restrict__ g, const float* __restrict__ modl, bf16* __restrict__ hn, bf16* __restrict__ hb, int row0, int nrows) {
    asm volatile("" : "+v"(lane));
    const int R = (nrows + nwaves - 1) / nwaves, ra0 = gwave * R, ra1 = min(ra0 + R, nrows);
    if (ra0 >= ra1) return;
    f32x4 gs[4], sf[4]; int cb = -1;
    f32x4 cur[2][4], nxt[2][4];
#pragma unroll
    for (int q = 0; q < 2; ++q) { const f32x4* x = (const f32x4*)(h + (size_t)(row0 + min(ra0 + q, ra1 - 1)) * DM) + lane;
#pragma unroll
        for (int j = 0; j < 4; ++j) cur[q][j] = x[64 * j]; }
    for (int rl = ra0; rl < ra1; rl += 2) {
        auto load_mod = [&](int b) { cb = b; const float* sh = modl + (size_t)b * 3072;
#pragma unroll
            for (int j = 0; j < 4; ++j) { const int col = (lane + 64 * j) * 4; gs[j] = *(const f32x4*)(g + col) * (*(const f32x4*)(sh + 1024 + col) + 1.0f); sf[j] = *(const f32x4*)(sh + col); } };
        if (rl + 2 < ra1) {
#pragma unroll
            for (int q = 0; q < 2; ++q) { const f32x4* x = (const f32x4*)(h + (size_t)(row0 + min(rl + 2 + q, ra1 - 1)) * DM) + lane;
#pragma unroll
                for (int j = 0; j < 4; ++j) nxt[q][j] = x[64 * j]; }
        }
#pragma unroll
        for (int q = 0; q < 2; ++q) {
            float ss = 0.f;
#pragma unroll
            for (int j = 0; j < 4; ++j) ss += (cur[q][j].x * cur[q][j].x + cur[q][j].y * cur[q][j].y) + (cur[q][j].z * cur[q][j].z + cur[q][j].w * cur[q][j].w);
            const float r = rsqrtf(wave_sum(ss) * (1.f / DM) + EPS);
            if (rl + q < ra1) { const int bq = (row0 + rl + q) >> 12; if (bq != cb) load_mod(bq);
                u32x2* o = (u32x2*)(hn + (size_t)(rl + q) * DM) + lane; u32x2* c = (u32x2*)(hb + (size_t)(row0 + rl + q) * DM) + lane;
#pragma unroll
                for (int j = 0; j < 4; ++j) { const f32x4 y = cur[q][j] * r * gs[j] + sf[j]; u32x2 w; w.x = pk2(y.x, y.y); w.y = pk2(y.z, y.w); o[64 * j] = w;
                    u32x2 cw; cw.x = pk2(cur[q][j].x, cur[q][j].y); cw.y = pk2(cur[q][j].z, cur[q][j].w); c[64 * j] = cw; }
            }
        }
#pragma unroll
        for (int q = 0; q < 2; ++q)
#pragma unroll
            for (int j = 0; j < 4; ++j) cur[q][j] = nxt[q][j];
    }
}

constexpr int MEGA_LDS = 147456, LDS_XS = 131072, LDS_QN = LDS_XS + 4096, LDS_MISC = MEGA_LDS - 128;
constexpr int CW_BAR = 4096;
constexpr size_t CTL_ZERO_BYTES = 64 * 1024;
struct MArgs { const float* in[32]; float* out; unsigned char* ws; int seq_lo, seq_hi; };
#define KIN(i) (kp->in[i])
#define WSP(T, off) ((T*)(kp->ws + (off)))
__global__ void __launch_bounds__(512, 2) mega(MArgs a_unused) {
    extern __shared__ __attribute__((aligned(16))) unsigned char lds[];
    typedef const MArgs __attribute__((address_space(4))) KA;
    volatile LAS unsigned* MISC = (volatile LAS unsigned*)((LAS unsigned char*)lds + LDS_MISC);
    const int wv0 = __builtin_amdgcn_readfirstlane((int)threadIdx.x >> 6);
    if (tidx(wv0) < 32) MISC[tidx(wv0)] = 0u;
    __syncthreads();
    int seq_lo, seq_hi;
    XcdBarrier bar;
    { KA* kp = (KA*)__builtin_amdgcn_kernarg_segment_ptr(); seq_lo = kp->seq_lo; seq_hi = kp->seq_hi; bar = xcd_barrier_post((unsigned*)(kp->ws + w2::CTL) + CW_BAR, MISC + 8, wv0); }
    PG8_LAS unsigned char* glds = (PG8_LAS unsigned char*)lds;
    int seq = 0;
#define PH_BEGIN if (seq >= seq_lo && seq < seq_hi) { {
#define CTX KA* kp = (KA*)__builtin_amdgcn_kernarg_segment_ptr(); int G = gridDim.x, cwg = blockIdx.x, tid = tidx(wv0); \
        asm volatile("" : "+s"(kp)); asm volatile("" : "+s"(G)); asm volatile("" : "+s"(cwg)); asm volatile("" : "+v"(tid)); const int lane = tid & 63, wv = __builtin_amdgcn_readfirstlane(tid >> 6); (void)lane; (void)wv;
#define SUB } { CTX
#define PH_END   } if (seq + 1 < seq_hi) xcd_barrier(bar, wv0); } ++seq;
#define GTID (cwg * 512 + tid)
#define NTHR (G * 512)

    PH_BEGIN CTX
        for (int it = (G == 256 ? cwg - 64 : cwg); it < 192; it += G) if (it >= 0) adaln_item((float*)lds, it, KIN(1), KIN(3), KIN(4), WSP(float, w2::MOD), wv0);
        SUB
        for (int eg = cwg; eg < 128; eg += G) s5_build_mats(lds, eg, KIN(7), KIN(8), KIN(9), KIN(10), KIN(11), KIN(12), KIN(13), KIN(14), WSP(bf16, w2::KC), WSP(bf16, w2::BMAT), WSP(float, w2::AT16), wv0);
        SUB
        {
            constexpr int T0 = 2048, T1 = T0 + 512, T2 = T1 + 128, T3 = T2 + 128, T4 = T3 + 128, T5 = T4 + 128, T6 = T5 + 1024, T7 = T6 + 1280, T8 = T7 + 512;
            float* tl = (float*)lds;
            static_assert(T8 == 64 * 31 + 64 * 11 + 128 * 25, "tile deal");
            int t_start = cwg, t_stride = G, t_cnt = (T8 - cwg + G - 1) / G;
            if (G == 256) { t_stride = 1; if (cwg < 64) { t_start = cwg * 31; t_cnt = 31; } else if (cwg < 128) { t_start = 64 * 31 + (cwg - 64) * 11; t_cnt = 11; } else { t_start = 64 * 31 + 64 * 11 + (cwg - 128) * 25; t_cnt = 25; } }
            for (int tj = 0; tj < t_cnt; ++tj) { const int it = t_start + tj * t_stride;
                if (it < T0) { const int z = it / 1024, t = it % 1024; wt_tile(tl, KIN(6) + (size_t)z * 1024 * 4096, 1024, 4096, WSP(bf16, w2::W_EIN) + (size_t)z * 1024 * 4096, t, 1.f, false, wv0); }
                else if (it < T1) { const int r = it - T0, z = r / 256, t = r % 256; wt_tile(tl, KIN(15) + (size_t)z * 1024 * 1024, 1024, 1024, WSP(bf16, w2::W_GLU) + (size_t)z * 1024 * 1024, t, 1.f, false, wv0); }
                else if (it < T3) { }
                else if (it < T4) { const int r = it - T3, z = r / 16, t = r % 16; wt_tile(tl, KIN(20) + (size_t)z * 65536, 256, 256, WSP(bf16, w2::W_V) + (size_t)z * 65536, t, 1.f, false, wv0); }
                else if (it < T5) { const int r = it - T4, z = r / 16, t = r % 16; wt_tile(tl, KIN(21) + (size_t)z * 65536, 256, 256, WSP(bf16, w2::W_O) + (size_t)z * 65536, t, 1.f, false, wv0); }
                else if (it < T6) { const int r = it - T5, z = r / 512, t = r % 512; wt_tile(tl, KIN(26) + (size_t)z * 2048 * 1024, 2048, 1024, WSP(bf16, w2::W_EOUT) + (size_t)z * 2048 * 1024, t, 1.f, false, wv0); }
                else if (it < T7) { const int r = it - T6, z = r / 640, t = r % 640; wt_tile(tl, KIN(27) + (size_t)z * 1024 * 2560, 1024, 2560, WSP(bf16, w2::W_OIN) + (size_t)z * 1024 * 2560, t, 1.f, true, wv0); }
                else { const int r = it - T7, z = r / 256, t = r % 256; wt_tile(tl, KIN(31) + (size_t)z * 1024 * 1024, 1024, 1024, WSP(bf16, w2::W_OOUT) + (size_t)z * 1024 * 1024, t, 1.f, false, wv0); }
            }
        }
        SUB
        for (int it = (G == 256 ? cwg - 128 : cwg); it < 8 * 16; it += G) if (it >= 0) {
            const int z = it >> 4, n0 = ((it >> 2) & 3) * 64, k0 = (it & 3) * 64;
            float* sq = (float*)lds; float* sk = sq + 64 * 257;
            for (int i = tid; i < 64 * 64; i += 512) { const int r = i >> 6, c4 = (i & 63) * 4;
                const f32x4 a = *(const f32x4*)(KIN(18) + (size_t)z * 65536 + (size_t)(k0 + r) * 256 + c4), b = *(const f32x4*)(KIN(19) + (size_t)z * 65536 + (size_t)(n0 + r) * 256 + c4);
                sq[r * 257 + c4] = a.x; sq[r * 257 + c4 + 1] = a.y; sq[r * 257 + c4 + 2] = a.z; sq[r * 257 + c4 + 3] = a.w; sk[r * 257 + c4] = b.x; sk[r * 257 + c4 + 1] = b.y; sk[r * 257 + c4 + 2] = b.z; sk[r * 257 + c4 + 3] = b.w; }
            __syncthreads();
            { const int kk = tid & 63, nb = (tid >> 6) * 8; float s[8];
#pragma unroll
              for (int a = 0; a < 8; ++a) s[a] = 0.f;
              for (int e1 = 0; e1 < 256; ++e1) { const float qv = sq[kk * 257 + e1];
#pragma unroll
                  for (int a = 0; a < 8; ++a) s[a] += sk[(nb + a) * 257 + e1] * qv; }
#pragma unroll
              for (int a = 0; a < 8; ++a) { const size_t o = (size_t)z * 65536 + (size_t)(n0 + nb + a) * 256 + k0 + kk;
                  WSP(bf16, w2::W_Q)[o] = f2bf(s[a] * 0.0625f); WSP(bf16, w2::W_K)[o] = (n0 + nb + a == k0 + kk) ? (bf16)0x3F80 : (bf16)0; } }
            __syncthreads();
        }
        for (int i = GTID; i < 2 * 16 * 2048; i += NTHR) { const int e2 = i >> 15, n = (i >> 11) & 15, k = i & 2047; WSP(bf16, w2::WIFT)[i] = (n < 8) ? f2bf(KIN(22)[((size_t)e2 * 2048 + k) * 8 + n]) : (bf16)0; }
        rope_table_items(GTID, NTHR, (const int*)KIN(2), WSP(float, w2::ROPE));
    PH_END

    for (int layer = 0; layer < DEPTH; ++layer) {
        if ((layer & 1) == 0) {
            const int e = layer >> 1;
            for (int half = 0; half < 2; ++half) {
                PH_BEGIN CTX
                    if (layer == 0) norm_rows(cwg * 8 + wv, G * 8, lane, KIN(0), KIN(5) + layer * 1024, WSP(float, w2::MOD) + (size_t)layer * 16 * 3072, WSP(bf16, w2::HN), (bf16*)kp->out, half * MH, MH);
                    else norm_rows_b(cwg * 8 + wv, G * 8, lane, (const bf16*)kp->out, KIN(5) + layer * 1024, WSP(float, w2::MOD) + (size_t)layer * 16 * 3072, WSP(bf16, w2::HN), half * MH, MH);
                PH_END
                PH_BEGIN CTX
                    pg8::Strided<SchedGrid> S; S.s0.ws = (const char*)kp->ws; S.s0.a_off = w2::HN; S.s0.b_off = w2::W_EIN + e * (4096u * 1024 * 2); S.s0.a_pm = 256u * 1024 * 2; S.s0.b_pn = 256u * 1024 * 2;
                    S.s0.nM = NTILE; S.s0.nN = 16; S.s0.lda = 1024; S.s0.ldb = 1024; S.s0.K = 1024; S.G = G; S.c = cwg;
                    pg8::Epi8<FEvenIn2> E; E.f.ws = kp->ws;
                    pg8::gemm_phase(glds, S, E, wv0);
                PH_END
                PH_BEGIN CTX
                    mlstm_gates_stage(lds, KIN(16) + e * 4096, KIN(17) + e * 1024, WSP(bf16, w2::WIFT) + (size_t)e * 16 * 2048, wv0);
                    for (int un = cwg; un < MH / 128; un += G) mlstm_gates_unit(lds, un, WSP(bf16, w2::MIN), KIN(23) + e * 8, WSP(bf16, w2::XC), WSP(float, w2::LI), WSP(float, w2::LF), wv0);
                    __syncthreads();
                    SUB
                    pg8::Strided<SchedS5> S; S.s0.ws = (const char*)kp->ws; S.s0.b_off = w2::BMAT + e * (64u * 65536 * 2); S.s0.b_g = 65536u * 2; S.s0.ldb = 256; S.s0.K = 256; S.G = G; S.c = cwg;
                    pg8::Epi8<FS5Z> E; E.f.ws = kp->ws;
                    pg8::gemm_phase(glds, S, E, wv0);
                    SUB
                    s5_scan_items((float*)lds, cwg, G, tid, WSP(float, w2::AT16) + (size_t)e * 64 * 128, WSP(bf16, w2::ZINC), WSP(bf16, w2::AU));
                    SUB
                    { pg8::Strided<SchedS5> S; S.s0.ws = (const char*)kp->ws; S.s0.b_off = w2::KC + e * (64u * 256 * AUP * 2); S.s0.b_g = 256u * AUP * 2; S.s0.ldb = AUP; S.s0.K = AUP; S.G = G; S.c = cwg;
                      EpiS5Y E; E.ws = kp->ws;
                      pg8::gemm_phase(glds, S, E, wv0); }
                PH_END
                PH_BEGIN CTX
                    for (int i = 0; i * G + cwg < 2 * NUNIT; ++i) { const int L = SchedProj::kv_index(i * G + cwg, G == 256);
                        if ((L & 7) < 4 && wv == (i & 7)) mlstm_chunk_scalars(lane, L >> 3, L & 3, WSP(float, w2::LI), WSP(float, w2::LF), WSP(float, w2::BCUM), WSP(float, w2::KAP), WSP(float, w2::PMX), WSP(float, w2::WEXP), WSP(float, w2::BT), WSP(float, w2::MLOC)); }
                    asm volatile("s_waitcnt vmcnt(0)" ::: "memory"); __syncthreads();
                    SUB
                    SchedProj S; S.pair = (G == 256); S.G = G; S.c = cwg;
                    S.s1.ws = (const char*)kp->ws; S.s1.w_off = w2::W_K + e * (4u * 65536 * 2);
                    EpiKV E; E.ws = kp->ws;
                    pg8::gemm_phase(glds, S, E, wv0);
                    SUB
                    if (G == 256) { pg8::Strided<SchedDC> S; S.s0.ws = (const char*)kp->ws; S.G = G; S.c = cwg;
                      pg8::Epi8<FDC> E; E.f.ws = kp->ws;
                      pg8::gemm_phase(glds, S, E, wv0); }
                PH_END
                if (gridDim.x != 256) {
                PH_BEGIN CTX
                    pg8::Strided<SchedDC> S; S.s0.ws = (const char*)kp->ws; S.G = G; S.c = cwg;
                    pg8::Epi8<FDC> E; E.f.ws = kp->ws;
                    pg8::gemm_phase(glds, S, E, wv0);
                PH_END
                }
                PH_BEGIN CTX
                    { pg8::Strided<SchedGrid> S; S.s0.ws = (const char*)kp->ws; S.s0.a_off = w2::Z; S.s0.b_off = w2::W_GLU + e * (1024u * 1024 * 2); S.s0.a_pm = 256u * 1024 * 2; S.s0.b_pn = 256u * 1024 * 2;
                      S.s0.nM = NTILE; S.s0.nN = 4; S.s0.lda = 1024; S.s0.ldb = 1024; S.s0.K = 1024; S.G = G; S.c = cwg;
                      EpiGlu E; E.ws = kp->ws;
                      pg8::gemm_phase(glds, S, E, wv0); }
                    SUB
                    mlstm_scan_items(GTID, NTHR, WSP(bf16, w2::CT), WSP(float, w2::BT), WSP(float, w2::MLOC), WSP(float, w2::DNP), WSP(float, w2::NST));
                PH_END
                PH_BEGIN CTX
                    { SchedQO S; S.G = G; S.c = cwg; S.s0.ws = (const char*)kp->ws; S.s0.w_off = w2::W_Q + e * (4u * 65536 * 2);
                      EpiXO E; E.base.f.ws = kp->ws; E.qnp = (PG8_LAS float*)(glds + LDS_QN);
                      pg8::gemm_phase(glds, S, E, wv0); }
                    SUB
                    { pg8::Strided<SchedS> S; S.s0.ws = (const char*)kp->ws; S.G = G; S.c = cwg;
                      EpiS E; E.ws = kp->ws;
                      pg8::gemm_phase(glds, S, E, wv0); }
                    SUB
                    SchedQP S; S.ws = (const char*)kp->ws; S.G = G; S.c = cwg;
                    EpiQP E; E.ws = kp->ws; E.ng = KIN(24) + e * 1024; E.skip = KIN(25) + e * 1024; E.qn = (PG8_LAS float*)(glds + LDS_QN); E.xs = (PG8_LAS float*)(glds + LDS_XS);
                    pg8::gemm_phase(glds, S, E, wv0);
                PH_END
                PH_BEGIN CTX
                    SchedOut2 S; S.ws = (const char*)kp->ws; S.b_off = w2::W_EOUT + e * (1024u * 2048 * 2); S.G = G; S.c = cwg;
                    EpiResidH E; E.hsrc = (const bf16*)kp->out; E.dst = kp->out; if (layer == DEPTH - 2) E.dst = WSP(bf16, w2::HC); E.dst_f32 = 0; E.ws = kp->ws; E.goff = w2::MOD + (layer * 16 * 3072 + 2048) * 4; E.row0 = half * MH;
                    pg8::gemm_phase(glds, S, E, wv0);
                PH_END
            }
        } else {
            const int o = layer >> 1;
            PH_BEGIN CTX
                const bf16* hsrc = (const bf16*)kp->out; if (layer == DEPTH - 1) hsrc = WSP(bf16, w2::HC);
                norm_rows_b(cwg * 8 + wv, G * 8, lane, hsrc, KIN(5) + layer * 1024, WSP(float, w2::MOD) + (size_t)layer * 16 * 3072, WSP(bf16, w2::HN), 0, MTOK);
            PH_END
            PH_BEGIN CTX
                pg8::Strided<SchedOddIn> S; S.s0.g.ws = (const char*)kp->ws; S.s0.g.a_off = w2::HN; S.s0.g.b_off = w2::W_OIN + o * (2560u * 1024 * 2); S.s0.g.a_pm = 256u * 1024 * 2; S.s0.g.b_pn = 256u * 1024 * 2;
                S.s0.g.nM = MTOK / 256; S.s0.g.nN = 10; S.s0.g.lda = 1024; S.s0.g.ldb = 1024; S.s0.g.K = 1024; S.G = G; S.c = cwg;
                EpiOddIn E; E.ws = kp->ws; E.qg = KIN(28) + o * 64; E.kg = KIN(29) + o * 64;
                pg8::gemm_phase(glds, S, E, wv0);
            PH_END
            PH_BEGIN CTX
                attn_phase(lds, G, cwg, WSP(bf16, w2::QO), WSP(bf16, w2::KO), WSP(bf16, w2::VTG), WSP(bf16, w2::ZO), KIN(30) + o * 16, WSP(bf16, w2::ABUF), wv0);
            PH_END
            PH_BEGIN CTX
                pg8::Strided<SchedGrid> S; S.s0.ws = (const char*)kp->ws; S.s0.a_off = w2::ABUF; S.s0.b_off = w2::W_OOUT + o * (1024u * 1024 * 2); S.s0.a_pm = 256u * 1024 * 2; S.s0.b_pn = 256u * 1024 * 2;
                S.s0.nM = MTOK / 256; S.s0.nN = 4; S.s0.lda = 1024; S.s0.ldb = 1024; S.s0.K = 1024; S.G = G; S.c = cwg;
                EpiResidH E; E.dst_f32 = layer == DEPTH - 1; E.hsrc = (const bf16*)kp->out; if (E.dst_f32) E.hsrc = WSP(bf16, w2::HC); E.dst = kp->out; E.ws = kp->ws; E.goff = w2::MOD + (layer * 16 * 3072 + 2048) * 4; E.row0 = 0;
                pg8::gemm_phase(glds, S, E, wv0);
            PH_END
        }
    }
#undef PH_BEGIN
#undef PH_END
}
constexpr int N_SEQ_MAX = 1 + 2 * 16 + 2 * 4;
__host__ __device__ constexpr int n_seq(int grid) { return grid == 256 ? N_SEQ_MAX - 4 : N_SEQ_MAX; }

#ifndef MEGA_MULTI
#define MEGA_MULTI 0
#endif
extern "C" void kernel_launch(void* const* d_in, const int* in_sizes, int n_in, void* d_out, int out_size, void* d_ws, size_t ws_size, hipStream_t stream) {
    static int grid = 0;
    if (grid == 0) {
        if (n_in != 32 || out_size != MTOK * DM || ws_size < w2::END) { fprintf(stderr, "kernel_launch: unexpected shapes (n_in %d, out %d, ws %zu)\n", n_in, out_size, ws_size); grid = -1; return; }
        int dev = 0, cus = 0, per_cu = 0;
        if (hipGetDevice(&dev) != hipSuccess || hipDeviceGetAttribute(&cus, hipDeviceAttributeMultiprocessorCount, dev) != hipSuccess) { grid = -1; return; }
        if (hipFuncSetAttribute((const void*)mega, hipFuncAttributeMaxDynamicSharedMemorySize, MEGA_LDS) != hipSuccess) { fprintf(stderr, "kernel_launch: hipFuncSetAttribute failed\n"); grid = -1; return; }
        if (hipOccupancyMaxActiveBlocksPerMultiprocessor(&per_cu, (const void*)mega, 512, MEGA_LDS) != hipSuccess || per_cu < 1) { fprintf(stderr, "kernel_launch: occupancy query says %d\n", per_cu); }
        (void)hipGetLastError();
        grid = cus;
        if (grid < 128) { fprintf(stderr, "kernel_launch: needs >= 128 CUs\n"); grid = -1; return; }
    }
    if (grid < 0) return;
    (void)hipMemsetAsync((char*)d_ws + w2::CTL, 0, CTL_ZERO_BYTES, stream);
    MArgs a; memset(&a, 0, sizeof a);
    for (int i = 0; i < 32; ++i) a.in[i] = (const float*)d_in[i];
    a.out = (float*)d_out; a.ws = (unsigned char*)d_ws;
#if MEGA_MULTI
    for (int s = 0; s < n_seq(grid); ++s) { a.seq_lo = s; a.seq_hi = s + 1; hipLaunchKernelGGL(mega, dim3(grid), dim3(512), MEGA_LDS, stream, a); }
#else
    a.seq_lo = 0; a.seq_hi = n_seq(grid);
    hipLaunchKernelGGL(mega, dim3(grid), dim3(512), MEGA_LDS, stream, a);
#endif
}
```

```cpp
#include <hip/hip_runtime.h>
#include <cstdio>
#include <cstdint>
#include <cstring>
#include <cmath>
namespace pg8 {
#define PG8_LAS __attribute__((address_space(3)))
typedef unsigned short bf16_t;
typedef short bf16x8 __attribute__((ext_vector_type(8)));
typedef float f32x4 __attribute__((ext_vector_type(4)));
typedef unsigned u32x4 __attribute__((ext_vector_type(4)));
typedef unsigned u32x2 __attribute__((ext_vector_type(2)));
constexpr int BM = 256, BK = 64, HALF = 128, HTB = HALF * BK * 2  , STAGE_BYTES = 8 * HTB, NXCD = 8;

__host__ __device__ __forceinline__ int lds_byte(int r, int c) { const int st = (r >> 4) * 2 + (c >> 5), rr = r & 15, cc = c & 31, ob = rr * 64 + cc * 2; return st * 1024 + (ob ^ (((ob >> 9) & 1) << 5)); }
__host__ __device__ __forceinline__ void stage_rc(int b, int& R, int& C) { const int st = b / 1024, sb = b % 1024, swz = sb ^ (((sb >> 9) & 1) << 5); R = (st >> 1) * 16 + swz / 64; C = (st & 1) * 32 + (swz % 64) / 2; }
__host__ __device__ __forceinline__ int perm32(int rho) { const int n = rho >> 4, i = rho & 15; return 8 * (i >> 2) + 4 * n + (i & 3); }

constexpr int UF_ZERO = 1, UF_EPI = 2, UF_MID = 4;
struct Unit { const char* A; const char* B; int pm, pn, z, flags, lda, ldb, K, kind; };

__device__ __forceinline__ int tidx(int wv0) { unsigned ones_ = ~0u; asm volatile("" : "+s"(ones_)); return (wv0 << 6) | (int)__builtin_amdgcn_mbcnt_hi(ones_, __builtin_amdgcn_mbcnt_lo(ones_, 0u)); }
__device__ __forceinline__ unsigned cvt_pk_bf16(float lo, float hi) { unsigned r; asm volatile("s_nop 0\n\tv_cvt_pk_bf16_f32 %0, %1, %2" : "=v"(r) : "v"(lo), "v"(hi)); return r; }

template <class F> struct Epi8 {
    static constexpr bool PERM = true;
    static constexpr int NV = F::NV;
    F f;
    __device__ __forceinline__ void mid(f32x4 (&)[2][2][4][2], const Unit&, int, int, int, int) const {}
    __device__ __forceinline__ void operator()(const f32x4 (&acc)[2][2][4][2], const Unit& u, int wr, int wc, int fr, int fq) const {
#pragma unroll
        for (int ai = 0; ai < 2; ++ai)
#pragma unroll
            for (int m = 0; m < 4; ++m) {
#pragma unroll
                for (int bj = 0; bj < 2; ++bj) f(u, ai * HALF + wr * 64 + m * 16 + fr, bj * HALF + wc * 32 + 8 * fq, acc[ai][bj][m][0], acc[ai][bj][m][1]);
                }
    }
};
template <class F> struct Epi4 {
    static constexpr bool PERM = false;
    static constexpr int NV = 0;
    F f;
    __device__ __forceinline__ void mid(f32x4 (&)[2][2][4][2], const Unit&, int, int, int, int) const {}
    __device__ __forceinline__ void operator()(const f32x4 (&acc)[2][2][4][2], const Unit& u, int wr, int wc, int fr, int fq) const {
#pragma unroll
        for (int ai = 0; ai < 2; ++ai)
#pragma unroll
            for (int m = 0; m < 4; ++m) {
#pragma unroll
                for (int bj = 0; bj < 2; ++bj)
#pragma unroll
                    for (int n = 0; n < 2; ++n) f(u, ai * HALF + wr * 64 + m * 16 + fr, bj * HALF + wc * 32 + n * 16 + 4 * fq, acc[ai][bj][m][n]);
                }
    }
};

template <class S0> struct Strided { S0 s0; int G, c; __device__ __forceinline__ bool next(int i, Unit& u) const { return s0.at(i * G + c, u); } };
template <class S0, class S1> struct Strided2 { S0 s0; S1 s1; int n0, G, c;
    __device__ __forceinline__ bool next(int i, Unit& u) const { const int L = i * G + c; if (L < n0) return s0.at(L, u); const bool ok = s1.at(L - n0, u); u.kind = 1; return ok; } };
template <class S0, class S1, class S2> struct Strided3 { S0 s0; S1 s1; S2 s2; int n0, n1, G, c;
    __device__ __forceinline__ bool next(int i, Unit& u) const { const int L = i * G + c; if (L < n0) return s0.at(L, u); if (L < n0 + n1) { const bool ok = s1.at(L - n0, u); u.kind = 1; return ok; } const bool ok = s2.at(L - n0 - n1, u); u.kind = 2; return ok; } };
template <class E0, class E1, bool SEAM_OK = true> struct EpiSel2 { static constexpr bool PERM = E0::PERM; static constexpr int NV = SEAM_OK ? (E0::NV < E1::NV ? E0::NV : E1::NV) : 0;     static_assert(E0::PERM == E1::PERM, "PERM"); E0 e0; E1 e1;
    __device__ __forceinline__ void mid(f32x4 (&)[2][2][4][2], const Unit&, int, int, int, int) const {}
    __device__ __forceinline__ void operator()(const f32x4 (&acc)[2][2][4][2], const Unit& u, int wr, int wc, int fr, int fq) const { if (u.kind == 0) e0(acc, u, wr, wc, fr, fq); else e1(acc, u, wr, wc, fr, fq); } };
template <class E0, class E1, class E2> struct EpiSel3 { static constexpr bool PERM = E0::PERM; static constexpr int NV = (E0::NV < E1::NV ? E0::NV : E1::NV) < E2::NV ? (E0::NV < E1::NV ? E0::NV : E1::NV) : E2::NV; static_assert(E0::PERM == E1::PERM && E0::PERM == E2::PERM, "PERM"); E0 e0; E1 e1; E2 e2;
    __device__ __forceinline__ void mid(f32x4 (&)[2][2][4][2], const Unit&, int, int, int, int) const {}
    __device__ __forceinline__ void operator()(const f32x4 (&acc)[2][2][4][2], const Unit& u, int wr, int wc, int fr, int fq) const { if (u.kind == 0) e0(acc, u, wr, wc, fr, fq); else if (u.kind == 1) e1(acc, u, wr, wc, fr, fq); else e2(acc, u, wr, wc, fr, fq); } };

template <class Epi, class Sched>
__device__ __forceinline__ void gemm_phase(PG8_LAS unsigned char* lds, const Sched& S, const Epi& E, int wv0) {
    int tid_ = tidx(wv0); asm volatile("" : "+v"(tid_));
    const int tid = tid_, wid = __builtin_amdgcn_readfirstlane(tid >> 6), lane = tid & 63, wr = wid >> 2, wc = wid & 3, fr = lane & 15, fq = lane >> 4;
    constexpr bool SEAM = Epi::NV >= 16;
    int Ra[2], Ca[2], Rb[2];
#pragma unroll
    for (int i = 0; i < 2; ++i) { int R, C; stage_rc(tid * 16 + i * 8192, R, C); Ra[i] = R; Ca[i] = C; Rb[i] = Epi::PERM ? ((R & ~31) + perm32(R & 31)) : R; }
    unsigned voffA[2], voffB[2];
    const size_t kstep = (size_t)(BK * 2);
    size_t hstepA, hstepB;
#define PG8_SETV(u) do { if (SEAM) { const int _tid = tidx(wv0); _Pragma("unroll") for (int _i = 0; _i < 2; ++_i) { int _R, _C; stage_rc(_tid * 16 + _i * 8192, _R, _C); const int _Rb = Epi::PERM ? ((_R & ~31) + perm32(_R & 31)) : _R; \
            voffA[_i] = (unsigned)(_R * (u).lda + _C) * 2u; voffB[_i] = (unsigned)(_Rb * (u).ldb + _C) * 2u; } } \
        else { _Pragma("unroll") for (int _i = 0; _i < 2; ++_i) { voffA[_i] = (unsigned)(Ra[_i] * (u).lda + Ca[_i]) * 2u; voffB[_i] = (unsigned)(Rb[_i] * (u).ldb + Ca[_i]) * 2u; } } \
        hstepA = (size_t)HALF * (u).lda * 2; hstepB = (size_t)HALF * (u).ldb * 2; } while (0)
    const unsigned ldsw = (unsigned)wid * 1024u;
    const int aoff = lds_byte(wr * 64 + fr, fq * 8), boff = lds_byte(wc * 32 + fr, fq * 8);
#define PG8_SA(b, h) (((b) * 2 + (h)) * HTB)
#define PG8_SB(b, h) ((4 + (b) * 2 + (h)) * HTB)
#define PG8_STAGE(bufoff, gbase, voff) do { _Pragma("unroll") for (int _i = 0; _i < 2; ++_i) \
        __builtin_amdgcn_global_load_lds((const unsigned*)((const char*)(gbase) + (voff)[_i]), (PG8_LAS unsigned*)(lds + (bufoff) + ldsw + _i * 8192), 16, 0, 0); } while (0)
#define PG8_LDA(dst, b, h) do { _Pragma("unroll") for (int m = 0; m < 4; ++m) _Pragma("unroll") for (int k = 0; k < 2; ++k) dst[m][k] = *(const PG8_LAS bf16x8*)(lds + PG8_SA(b, h) + aoff + m * 2048 + k * 1024); } while (0)
#define PG8_LDB(dst, b, h) do { _Pragma("unroll") for (int n = 0; n < 2; ++n) _Pragma("unroll") for (int k = 0; k < 2; ++k) dst[n][k] = *(const PG8_LAS bf16x8*)(lds + PG8_SB(b, h) + boff + n * 2048 + k * 1024); } while (0)
#define PG8_MMA(ai, bj, At, Bt) do { __builtin_amdgcn_s_setprio(1); _Pragma("unroll") for (int m = 0; m < 4; ++m) _Pragma("unroll") for (int n = 0; n < 2; ++n) _Pragma("unroll") for (int k = 0; k < 2; ++k) \
        acc[ai][bj][m][n] = __builtin_amdgcn_mfma_f32_16x16x32_bf16(Bt[n][k], At[m][k], acc[ai][bj][m][n], 0, 0, 0); __builtin_amdgcn_s_setprio(0); } while (0)
#define PG8_WAIT_V(n) asm volatile("s_waitcnt vmcnt(" #n ")" ::: "memory")
#define PG8_WAIT_L(n) asm volatile("s_waitcnt lgkmcnt(" #n ")" ::: "memory")
#define PG8_BAR __builtin_amdgcn_s_barrier()
#define PG8_SCHED __builtin_amdgcn_sched_barrier(0)
    Unit cur, nxt; int ui = 0;
    if (!S.next(0, cur)) return;
    f32x4 acc[2][2][4][2];
#pragma unroll
    for (int a = 0; a < 2; ++a)
#pragma unroll
        for (int b = 0; b < 2; ++b)
#pragma unroll
            for (int m = 0; m < 4; ++m)
#pragma unroll
                for (int n = 0; n < 2; ++n) acc[a][b][m][n] = (f32x4){0.f, 0.f, 0.f, 0.f};
    bf16x8 At[4][2], B0[2][2], B1[2][2];
    const char* cA = cur.A; const char* cB = cur.B;
    PG8_SETV(cur);
    PG8_STAGE(PG8_SB(0, 0), cB, voffB); PG8_STAGE(PG8_SB(0, 1), cB + hstepB, voffB); PG8_STAGE(PG8_SA(0, 0), cA, voffA); PG8_STAGE(PG8_SA(0, 1), cA + hstepA, voffA);
    if (wr == 1) PG8_BAR;
    PG8_WAIT_V(2); PG8_BAR;
    PG8_STAGE(PG8_SB(1, 0), cB + kstep, voffB); PG8_STAGE(PG8_SA(1, 0), cA + kstep, voffA); PG8_STAGE(PG8_SB(1, 1), cB + hstepB + kstep, voffB);
    PG8_WAIT_V(6); PG8_BAR;
    bool pre = false, relax = false;
    for (;;) {
        const bool has_next = S.next(ui + 1, nxt);
        const char* nA = has_next ? nxt.A : cA; const char* nB = has_next ? nxt.B : cB;
        const int nt = cur.K / BK;
        for (int t = 0; t < nt; t += 2) {
            const bool last = (t == nt - 2);
            const char* a1 = cA + (size_t)(t + 1) * kstep;
            const char* a2 = last ? nA : cA + (size_t)(t + 2) * kstep; const char* b2 = last ? nB : cB + (size_t)(t + 2) * kstep;
            const char* a3 = a2 + kstep; const char* b3 = b2 + kstep;
            const bool rx = relax && (t == 0);
            PG8_LDB(B0, 0, 0); PG8_LDB(B1, 0, 1); PG8_SCHED; PG8_LDA(At, 0, 0); if (!(pre && t == 0)) PG8_STAGE(PG8_SA(1, 1), a1 + hstepA, voffA);
            if (rx) PG8_WAIT_V(24); else PG8_WAIT_V(8);
            PG8_WAIT_L(0); PG8_BAR; PG8_MMA(0, 0, At, B0); PG8_MMA(0, 1, At, B1); PG8_BAR; PG8_SCHED;
            if (last && has_next) PG8_SETV(nxt);
            PG8_LDA(At, 0, 1); PG8_STAGE(PG8_SB(0, 0), b2, voffB); PG8_STAGE(PG8_SB(0, 1), b2 + hstepB, voffB); PG8_STAGE(PG8_SA(0, 0), a2, voffA);
            if (rx) PG8_WAIT_V(24); else PG8_WAIT_V(8);
            PG8_WAIT_L(0); PG8_BAR; PG8_MMA(1, 0, At, B0); PG8_MMA(1, 1, At, B1); PG8_BAR; PG8_SCHED;
            PG8_LDB(B0, 1, 0); PG8_LDB(B1, 1, 1); PG8_SCHED; PG8_LDA(At, 1, 0); PG8_STAGE(PG8_SA(0, 1), a2 + hstepA, voffA);
            if (rx) PG8_WAIT_V(24); else PG8_WAIT_V(8);
            PG8_WAIT_L(0); PG8_BAR; PG8_MMA(0, 0, At, B0); PG8_MMA(0, 1, At, B1); PG8_BAR; PG8_SCHED;
            PG8_LDA(At, 1, 1); PG8_STAGE(PG8_SB(1, 0), b3, voffB); PG8_STAGE(PG8_SB(1, 1), b3 + hstepB, voffB); PG8_STAGE(PG8_SA(1, 0), a3, voffA);
            PG8_WAIT_V(8); PG8_WAIT_L(0); PG8_BAR; PG8_MMA(1, 0, At, B0); PG8_MMA(1, 1, At, B1); PG8_BAR; PG8_SCHED;
        }
        if (wr == 0) PG8_BAR;
        if (SEAM && has_next) PG8_STAGE(PG8_SA(1, 1), nA + kstep + hstepA, voffA);
        { unsigned ones_ = ~0u; asm volatile("" : "+s"(ones_)); const int lid_ = (int)__builtin_amdgcn_mbcnt_hi(ones_, __builtin_amdgcn_mbcnt_lo(ones_, 0u));
          const int fr_ = lid_ & 15, fq_ = lid_ >> 4;
          if (cur.flags & UF_EPI) E(acc, cur, wr, wc, fr_, fq_);
          if (cur.flags & UF_MID) E.mid(acc, cur, wr, wc, fr_, fq_); }
        if (!has_next) break;
        if (nxt.flags & UF_ZERO) {
#pragma unroll
        for (int a = 0; a < 2; ++a)
#pragma unroll
            for (int b = 0; b < 2; ++b)
#pragma unroll
                for (int m = 0; m < 4; ++m)
#pragma unroll
                    for (int n = 0; n < 2; ++n) acc[a][b][m][n] = (f32x4){0.f, 0.f, 0.f, 0.f};
        }
        pre = SEAM; relax = SEAM && (cur.flags & UF_EPI);
        cur = nxt; cA = nA; cB = nB; ++ui;
        if (wr == 1) PG8_BAR;
    }
    PG8_WAIT_V(0);
    PG8_BAR;
#undef PG8_SA
#undef PG8_SETV
#undef PG8_SB
#undef PG8_STAGE
#undef PG8_LDA
#undef PG8_LDB
#undef PG8_MMA
#undef PG8_WAIT_V
#undef PG8_WAIT_L
#undef PG8_BAR
#undef PG8_SCHED
}
}
typedef unsigned short bf16;
typedef float f32x4 __attribute__((ext_vector_type(4)));
typedef unsigned u32x4 __attribute__((ext_vector_type(4)));
typedef unsigned u32x2 __attribute__((ext_vector_type(2)));
constexpr int DM = 1024, NB = 16, SEQ = 4096, MTOK = NB * SEQ, MH = MTOK / 2, DEPTH = 4;
constexpr float EPS = 1e-6f;
constexpr size_t MiB = 1u << 20;
constexpr size_t WS_CTL = 0;
constexpr size_t WS_MOD = 1 * MiB;
constexpr size_t WS_W_EIN = 4 * MiB;
constexpr size_t WS_W_GLU = 20 * MiB;
constexpr size_t WS_W_Q = 24 * MiB, WS_W_K = 25 * MiB, WS_W_V = 26 * MiB, WS_W_O = 27 * MiB;
constexpr size_t WS_W_EOUT = 28 * MiB;
constexpr size_t WS_W_OIN = 36 * MiB;
constexpr size_t WS_W_OOUT = 46 * MiB;
constexpr size_t WS_HN = 64 * MiB;
constexpr size_t WS_PROJ = 192 * MiB;
constexpr size_t WS_Y2 = 448 * MiB;
constexpr size_t WS_YCAT = 512 * MiB;
constexpr size_t WS_XC = 640 * MiB;
constexpr size_t WS_Q = 704 * MiB, WS_K = 768 * MiB, WS_V = 832 * MiB, WS_O = 896 * MiB;
constexpr size_t WS_LI = 960 * MiB, WS_LF = 961 * MiB;
constexpr size_t WS_END = 962 * MiB;

__device__ __forceinline__ float bf2f(unsigned u) { return __uint_as_float(u << 16); }
__device__ __forceinline__ float bflo(unsigned w) { return __uint_as_float(w << 16); }
__device__ __forceinline__ float bfhi(unsigned w) { return __uint_as_float(w & 0xffff0000u); }
__device__ __forceinline__ unsigned pk2(float lo, float hi) { return pg8::cvt_pk_bf16(lo, hi); }
__device__ __forceinline__ bf16 f2bf(float f) { return (bf16)(pg8::cvt_pk_bf16(f, 0.f) & 0xffffu); }
__device__ __forceinline__ float silu_f(float x) { return x * __builtin_amdgcn_rcpf(1.f + __expf(-x)); }
__device__ __forceinline__ float sigmoid_f(float x) { return __builtin_amdgcn_rcpf(1.f + __expf(-x)); }
__device__ __forceinline__ float gelu_tanh_f(float x) { const float u2 = 1.5957691216057308f * (x + 0.044715f * x * x * x); return x * __builtin_amdgcn_rcpf(1.f + __expf(-u2)); }
__device__ __forceinline__ float log_sigmoid_f(float x) { return fminf(x, 0.f) - 0.6931471805599453f * __builtin_amdgcn_logf(1.f + __expf(-fabsf(x))); }
__device__ __forceinline__ int tidx(int wv0) { unsigned ones_ = ~0u; asm volatile("" : "+s"(ones_)); return (wv0 << 6) | (int)__builtin_amdgcn_mbcnt_hi(ones_, __builtin_amdgcn_mbcnt_lo(ones_, 0u)); }
template <int CTRL> __device__ __forceinline__ float dpp_t(float v) { return __uint_as_float((unsigned)__builtin_amdgcn_mov_dpp((int)__float_as_uint(v), CTRL, 0xF, 0xF, true)); }
#define dpp_f(v, ctrl) dpp_t<ctrl>(v)
#define DPP_XOR1 0xB1
#define DPP_XOR2 0x4E
#define DPP_HMIRROR 0x141
#define DPP_MIRROR 0x140
__device__ __forceinline__ float sum_x16(float v) { auto r = __builtin_amdgcn_permlane16_swap(__float_as_uint(v), __float_as_uint(v), false, false); return __uint_as_float(r[0]) + __uint_as_float(r[1]); }
__device__ __forceinline__ float sum_x32(float v) { auto r = __builtin_amdgcn_permlane32_swap(__float_as_uint(v), __float_as_uint(v), false, false); return __uint_as_float(r[0]) + __uint_as_float(r[1]); }
__device__ __forceinline__ float max_x16(float v) { auto r = __builtin_amdgcn_permlane16_swap(__float_as_uint(v), __float_as_uint(v), false, false); return fmaxf(__uint_as_float(r[0]), __uint_as_float(r[1])); }
__device__ __forceinline__ float max_x32(float v) { auto r = __builtin_amdgcn_permlane32_swap(__float_as_uint(v), __float_as_uint(v), false, false); return fmaxf(__uint_as_float(r[0]), __uint_as_float(r[1])); }
__device__ __forceinline__ float other_x16(float v, int lane) { auto r = __builtin_amdgcn_permlane16_swap(__float_as_uint(v), __float_as_uint(v), false, false); return __uint_as_float((lane & 16) ? r[0] : r[1]); }
__device__ __forceinline__ float sum_row16(float v) { v += dpp_f(v, DPP_XOR1); v += dpp_f(v, DPP_XOR2); v += dpp_f(v, DPP_HMIRROR); v += dpp_f(v, DPP_MIRROR); return v; }
__device__ __forceinline__ float max_row16(float v) { v = fmaxf(v, dpp_f(v, DPP_XOR1)); v = fmaxf(v, dpp_f(v, DPP_XOR2)); v = fmaxf(v, dpp_f(v, DPP_HMIRROR)); v = fmaxf(v, dpp_f(v, DPP_MIRROR)); return v; }
__device__ __forceinline__ float wave_sum(float v) { return sum_x32(sum_x16(sum_row16(v))); }
__device__ __forceinline__ float wave_max(float v) { return max_x32(max_x16(max_row16(v))); }
namespace w2 {
constexpr size_t CTL = 0, MOD = 1 * MiB, AT16 = 2 * MiB;
constexpr size_t BCUM = 3 * MiB, KAP = BCUM + 512 * 1024, PMX = 4 * MiB, WEXP = PMX + 512 * 1024, BT = 5 * MiB, MLOC = BT + 4096;
constexpr size_t LI = 11 * MiB, LF = LI + 512 * 1024, WIFT = 2 * MiB + 256 * 1024;
constexpr size_t DNP = 6 * MiB, NST = 8 * MiB, DSP = 9 * MiB, ROPE = 12 * MiB;
constexpr size_t W_EIN = 16 * MiB, W_GLU = 32 * MiB, W_Q = 36 * MiB, W_K = 37 * MiB, W_V = 38 * MiB, W_O = 39 * MiB, W_EOUT = 40 * MiB, W_OIN = 48 * MiB, W_OOUT = 58 * MiB;
constexpr size_t KC = 62 * MiB, BMAT = 86 * MiB;
constexpr size_t HN = 104 * MiB;
constexpr size_t AU = 168 * MiB;
constexpr size_t ZS = 264 * MiB, MIN = 328 * MiB  , MZS = 392 * MiB, XC = 456 * MiB, Q = 520 * MiB, K = 584 * MiB, O = 648 * MiB;
constexpr size_t KWT = 712 * MiB  , VT = 776 * MiB, CT = 840 * MiB, Z = 904 * MiB  , ZINC = 968 * MiB  , END = 1000 * MiB;
constexpr size_t QO = 232 * MiB, KO = 360 * MiB, VTG = 392 * MiB, ZO = 424 * MiB, ABUF = 840 * MiB;
constexpr size_t HC = K;
static_assert(MIN == ZS + 64 * MiB && MZS == ZS + 128 * MiB && K == Q + 64 * MiB && O == Q + 128 * MiB && VT == KWT + 64 * MiB && W_K == W_Q + MiB && W_V == W_K + MiB && W_O == W_Q + 3 * MiB, "offset arithmetic in the schedules");
}
constexpr int S5T = 16, AUP = 384, S5ROWS = (MH / S5T);

__device__ __forceinline__ void s5_build_mats(unsigned char* smem, int eg, const float* a_re, const float* a_im, const float* log_dt, const float* b_re, const float* b_im,
                                              const float* c_re, const float* c_im, const float* d_skip, bf16* KC, bf16* BMAT, float* AT16, int wv0) {
    float* pwr = (float*)smem; float* pwi = pwr + 17 * 64; float* bbr = pwi + 17 * 64; float* bbi = bbr + 1024; float* kt = bbi + 1024;
    int tid_ = tidx(wv0); asm volatile("" : "+v"(tid_)); const int tid = tid_, g = eg & 63;
    const float* are = a_re + eg * 64; const float* aim = a_im + eg * 64; const float* bre = b_re + (size_t)eg * 1024; const float* bim = b_im + (size_t)eg * 1024;
    const float* cre = c_re + (size_t)eg * 1024; const float* cim = c_im + (size_t)eg * 1024;
    (void)g;
    if (tid < 64) {
        const int n = tid;
        const double dt = exp((double)log_dt[eg]);
        const double ar = are[n], ai = aim[n];
        for (int k = 0; k <= 16; ++k) { const double er = exp(ar * dt * k); pwr[k * 64 + n] = (float)(er * cos(ai * dt * k)); pwi[k * 64 + n] = (float)(er * sin(ai * dt * k)); }
        const double er = exp(ar * dt), abr = er * cos(ai * dt), abi = er * sin(ai * dt);
        const double nr = abr - 1.0, ni = abi, den = ar * ar + ai * ai;
        const double fr = (nr * ar + ni * ai) / den, fi = (ni * ar - nr * ai) / den;
        for (int q = 0; q < 16; ++q) { const double br = bre[n * 16 + q], bi = bim[n * 16 + q]; bbr[n * 16 + q] = (float)(fr * br - fi * bi); bbi[n * 16 + q] = (float)(fr * bi + fi * br); }
        AT16[(size_t)eg * 128 + 2 * n] = pwr[16 * 64 + n]; AT16[(size_t)eg * 128 + 2 * n + 1] = pwi[16 * 64 + n];
    }
    __syncthreads();
    for (int idx = tid; idx < 16 * 256; idx += 512) {
        const int tau = idx >> 8, p = (idx >> 4) & 15, q = idx & 15;
        float s = 0.f;
        for (int n = 0; n < 64; ++n) { const float cr = cre[p * 64 + n], ci = cim[p * 64 + n], wr = pwr[tau * 64 + n], wi = pwi[tau * 64 + n];
            const float xr = cr * wr - ci * wi, xi = cr * wi + ci * wr;
            s += xr * bbr[n * 16 + q] - xi * bbi[n * 16 + q]; }
        kt[idx] = s + ((tau == 0 && p == q) ? d_skip[eg * 16 + p] : 0.f);
    }
    __syncthreads();
    bf16* kc = KC + (size_t)eg * 256 * AUP; bf16* bm = BMAT + (size_t)eg * 256 * 256;
    for (int idx = tid; idx < 256 * 256; idx += 512) {
        const int row = idx >> 8, col = idx & 255, j = row >> 4, p = row & 15, i = col >> 4, q = col & 15;
        kc[(size_t)row * AUP + col] = (i <= j) ? f2bf(kt[((j - i) << 8) + p * 16 + q]) : (bf16)0;
    }
    for (int idx = tid; idx < 256 * 64; idx += 512) {
        const int row = idx >> 6, n = idx & 63, j = row >> 4, p = row & 15;
        const float cr = cre[p * 64 + n], ci = cim[p * 64 + n], wr = pwr[(j + 1) * 64 + n], wi = pwi[(j + 1) * 64 + n];
        kc[(size_t)row * AUP + 256 + n] = f2bf(cr * wr - ci * wi); kc[(size_t)row * AUP + 320 + n] = f2bf(-(cr * wi + ci * wr));
    }
    for (int idx = tid; idx < 256 * 256; idx += 512) {
        const int row = idx >> 8, col = idx & 255, i = col >> 4, q = col & 15;
        float v = 0.f;
        if (row < 128) { const int n = row & 63; const float wr = pwr[(15 - i) * 64 + n], wi = pwi[(15 - i) * 64 + n], br = bbr[n * 16 + q], bi = bbi[n * 16 + q];
            v = (row < 64) ? (wr * br - wi * bi) : (wr * bi + wi * br); }
        bm[(size_t)row * 256 + col] = f2bf(v);
    }
    __syncthreads();
}

__device__ __forceinline__ void s5_scan_items(float* sm  , int cwg, int G, int tid, const float* AT16e, const bf16* Z, bf16* AU) {
    asm volatile("" : "+v"(tid));
    const int lane = tid & 63, w = __builtin_amdgcn_readfirstlane(tid >> 6);
    __syncthreads();
    for (int it = cwg; it < 512; it += 2 * G) {
        const int combo = min(it + G * (lane >> 5), 511), g = combo >> 3, bl = combo & 7, p = lane & 31; const bool live = it + G * (lane >> 5) < 512;
        const f32x4 a = *(const f32x4*)(AT16e + g * 128 + 4 * p);
        const size_t row0 = (size_t)g * S5ROWS + (size_t)bl * 256 + w * 32;
        const unsigned* zp = (const unsigned*)(Z + row0 * 128) + p;
        unsigned zr[32], zi[32];
#pragma unroll
        for (int k = 0; k < 32; ++k) { zr[k] = zp[k * 64]; zi[k] = zp[k * 64 + 32]; }
        __builtin_amdgcn_sched_barrier(0);
        float s0r = 0.f, s0i = 0.f, s1r = 0.f, s1i = 0.f;
#pragma unroll
        for (int k = 0; k < 32; ++k) {
            unsigned wr_ = zr[k], wi_ = zi[k]; asm volatile("" : "+v"(s0r), "+v"(wr_), "+v"(wi_));
            const float n0r = a.x * s0r - a.y * s0i + bflo(wr_), n0i = a.x * s0i + a.y * s0r + bflo(wi_);
            const float n1r = a.z * s1r - a.w * s1i + bfhi(wr_), n1i = a.z * s1i + a.w * s1r + bfhi(wi_);
            s0r = n0r; s0i = n0i; s1r = n1r; s1i = n1i;
        }
        float q0r = a.x, q0i = a.y, q1r = a.z, q1i = a.w;
#pragma unroll
        for (int j = 0; j < 5; ++j) { const float t0 = q0r * q0r - q0i * q0i, t1 = 2.f * q0r * q0i, t2 = q1r * q1r - q1i * q1i, t3 = 2.f * q1r * q1i; q0r = t0; q0i = t1; q1r = t2; q1i = t3; }
        *(f32x4*)(sm + (w * 64 + lane) * 4) = (f32x4){s0r, s0i, s1r, s1i};
        __syncthreads();
        s0r = 0.f; s0i = 0.f; s1r = 0.f; s1i = 0.f;
        for (int j = 0; j < w; ++j) { const f32x4 e = *(const f32x4*)(sm + (j * 64 + lane) * 4);
            const float n0r = q0r * s0r - q0i * s0i + e.x, n0i = q0r * s0i + q0i * s0r + e.y, n1r = q1r * s1r - q1i * s1i + e.z, n1i = q1r * s1i + q1i * s1r + e.w;
            s0r = n0r; s0i = n0i; s1r = n1r; s1i = n1i; }
        unsigned* sp = (unsigned*)(AU + row0 * AUP + 256) + p;
#pragma unroll
        for (int k = 0; k < 32; ++k) {
            unsigned wr_ = zr[k], wi_ = zi[k]; asm volatile("" : "+v"(s0r), "+v"(wr_), "+v"(wi_));
            if (live) { sp[k * (AUP / 2)] = pk2(s0r, s1r); sp[k * (AUP / 2) + 32] = pk2(s0i, s1i); }
            const float n0r = a.x * s0r - a.y * s0i + bflo(wr_), n0i = a.x * s0i + a.y * s0r + bflo(wi_);
            const float n1r = a.z * s1r - a.w * s1i + bfhi(wr_), n1i = a.z * s1i + a.w * s1r + bfhi(wi_);
            s0r = n0r; s0i = n0i; s1r = n1r; s1i = n1i;
        }
        __syncthreads();
    }
}
constexpr int NTILE = MH / 256;
constexpr int NUNIT = NTILE * 4;

typedef short bf16x8_m __attribute__((ext_vector_type(8)));
constexpr int GT_WP = 4112;
constexpr int GT_CW_OFF = 16 * GT_WP;
__device__ __forceinline__ void mlstm_gates_stage(unsigned char* sm, const float* __restrict__ conv_w, const float* __restrict__ conv_b, const bf16* __restrict__ WIFT, int wv0) {
    int tid_ = tidx(wv0); asm volatile("" : "+v"(tid_)); const int tid = tid_;
    for (int p = tid; p < 16 * 256; p += 512) { const int n = p >> 8, part = p & 255; *(u32x4*)(sm + n * GT_WP + part * 16) = *(const u32x4*)(WIFT + (size_t)n * 2048 + part * 8); }
    for (int p = tid; p < 1280; p += 512) { const f32x4 v = (p < 1024) ? *(const f32x4*)(conv_w + p * 4) : *(const f32x4*)(conv_b + (p - 1024) * 4); *(f32x4*)(sm + GT_CW_OFF + p * 16) = v; }
    __syncthreads();
}
__device__ __forceinline__ void mlstm_gates_unit(const unsigned char* sm, int unit, const bf16* __restrict__ MIN, const float* __restrict__ b_if, bf16* __restrict__ XC, float* __restrict__ LI, float* __restrict__ LF, int wv0) {
    int tid_ = tidx(wv0); asm volatile("" : "+v"(tid_)); const int tid = tid_, lane = tid & 63, wv = tid >> 6, l15 = lane & 15, kg = lane >> 4;
    const int row = unit * 128 + wv * 16 + l15, t = row & (SEQ - 1);
    pg8::f32x4 acc = (pg8::f32x4){0.f, 0.f, 0.f, 0.f};
    const bf16* mp = MIN + (size_t)row * 1024 + kg * 8;
    const unsigned char* wp = sm + l15 * GT_WP + kg * 16;
    const float* cw = (const float*)(sm + GT_CW_OFF) + kg * 8;
    const bool halo = (l15 < 3) && ((row - l15) & (SEQ - 1)) != 0;
    const bf16* hp = halo ? mp - (size_t)(2 * l15 + 1) * 1024 : mp;
    (void)t;
    u32x4 xa[8], ha[8], xb[8], hb[8];
    auto step = [&](const u32x4 x0, const u32x4 hraw, const int ks) {
        const int c0 = ks * 32 + kg * 8;
        const u32x4 z4 = (u32x4){0u, 0u, 0u, 0u};
        const u32x4 hx = halo ? hraw : z4;
        u32x4 x1, x2, x3;
#define GT_SHR(n, v) (unsigned)__builtin_amdgcn_mov_dpp((int)(v), 0x110 + (n), 0xF, 0xF, true)
#define GT_QP(c, v)  (unsigned)__builtin_amdgcn_mov_dpp((int)(v), (c), 0xF, 0xF, true)
        u32x4 s1, s2, s3, h2, h3;
        s1.x = GT_SHR(1, x0.x); s1.y = GT_SHR(1, x0.y); s1.z = GT_SHR(1, x0.z); s1.w = GT_SHR(1, x0.w);
        s2.x = GT_SHR(2, x0.x); s2.y = GT_SHR(2, x0.y); s2.z = GT_SHR(2, x0.z); s2.w = GT_SHR(2, x0.w);
        s3.x = GT_SHR(3, x0.x); s3.y = GT_SHR(3, x0.y); s3.z = GT_SHR(3, x0.z); s3.w = GT_SHR(3, x0.w);
        h2.x = GT_QP(0xB1, hx.x); h2.y = GT_QP(0xB1, hx.y); h2.z = GT_QP(0xB1, hx.z); h2.w = GT_QP(0xB1, hx.w);
        h3.x = GT_QP(0xC6, hx.x); h3.y = GT_QP(0xC6, hx.y); h3.z = GT_QP(0xC6, hx.z); h3.w = GT_QP(0xC6, hx.w);
        x1 = (l15 >= 1) ? s1 : hx; x2 = (l15 >= 2) ? s2 : h2; x3 = (l15 >= 3) ? s3 : h3;
#undef GT_SHR
#undef GT_QP
        const bf16x8_m bx = *(const bf16x8_m*)(wp + ks * 64), bm = *(const bf16x8_m*)(wp + 2048 + ks * 64);
        f32x4 a0 = *(const f32x4*)(cw + 4096 + ks * 32), a1 = *(const f32x4*)(cw + 4096 + ks * 32 + 4);
        { const f32x4 w0 = *(const f32x4*)(cw + 3 * 1024 + ks * 32), w1 = *(const f32x4*)(cw + 3 * 1024 + ks * 32 + 4);
          a0 += (f32x4){bflo(x0.x), bfhi(x0.x), bflo(x0.y), bfhi(x0.y)} * w0; a1 += (f32x4){bflo(x0.z), bfhi(x0.z), bflo(x0.w), bfhi(x0.w)} * w1; }
        { const f32x4 w0 = *(const f32x4*)(cw + 2 * 1024 + ks * 32), w1 = *(const f32x4*)(cw + 2 * 1024 + ks * 32 + 4);
          a0 += (f32x4){bflo(x1.x), bfhi(x1.x), bflo(x1.y), bfhi(x1.y)} * w0; a1 += (f32x4){bflo(x1.z), bfhi(x1.z), bflo(x1.w), bfhi(x1.w)} * w1; }
        { const f32x4 w0 = *(const f32x4*)(cw + 1 * 1024 + ks * 32), w1 = *(const f32x4*)(cw + 1 * 1024 + ks * 32 + 4);
          a0 += (f32x4){bflo(x2.x), bfhi(x2.x), bflo(x2.y), bfhi(x2.y)} * w0; a1 += (f32x4){bflo(x2.z), bfhi(x2.z), bflo(x2.w), bfhi(x2.w)} * w1; }
        { const f32x4 w0 = *(const f32x4*)(cw + ks * 32), w1 = *(const f32x4*)(cw + ks * 32 + 4);
          a0 += (f32x4){bflo(x3.x), bfhi(x3.x), bflo(x3.y), bfhi(x3.y)} * w0; a1 += (f32x4){bflo(x3.z), bfhi(x3.z), bflo(x3.w), bfhi(x3.w)} * w1; }
        u32x4 xo; xo.x = pk2(silu_f(a0.x), silu_f(a0.y)); xo.y = pk2(silu_f(a0.z), silu_f(a0.w)); xo.z = pk2(silu_f(a1.x), silu_f(a1.y)); xo.w = pk2(silu_f(a1.z), silu_f(a1.w));
        *(u32x4*)(XC + (size_t)row * 1024 + c0) = xo;
        acc = __builtin_amdgcn_mfma_f32_16x16x32_bf16(__builtin_bit_cast(bf16x8_m, xo), bx, acc, 0, 0, 0);
        acc = __builtin_amdgcn_mfma_f32_16x16x32_bf16(__builtin_bit_cast(bf16x8_m, x0), bm, acc, 0, 0, 0);
    };
#pragma unroll
    for (int j = 0; j < 8; ++j) { xa[j] = *(const u32x4*)(mp + j * 32); ha[j] = *(const u32x4*)(hp + j * 32); }
#pragma unroll 1
    for (int kb = 0; kb < 32; kb += 16) {
#pragma unroll
        for (int j = 0; j < 8; ++j) { xb[j] = *(const u32x4*)(mp + (kb + 8 + j) * 32); hb[j] = *(const u32x4*)(hp + (kb + 8 + j) * 32); }
#pragma unroll
        for (int j = 0; j < 8; ++j) step(xa[j], ha[j], kb + j);
        if (kb + 16 < 32) {
#pragma unroll
            for (int j = 0; j < 8; ++j) { xa[j] = *(const u32x4*)(mp + (kb + 16 + j) * 32); ha[j] = *(const u32x4*)(hp + (kb + 16 + j) * 32); }
        }
#pragma unroll
        for (int j = 0; j < 8; ++j) step(xb[j], hb[j], kb + 8 + j);
    }
    if (l15 < 8) {
        const float bias = b_if[l15]; const int r0 = unit * 128 + wv * 16 + 4 * kg;
#pragma unroll
        for (int r = 0; r < 4; ++r) { const float v = acc[r] + bias;
            if (l15 < 4) LI[(size_t)(r0 + r) * 4 + l15] = v; else LF[(size_t)(r0 + r) * 4 + (l15 - 4)] = log_sigmoid_f(v); }
    }
}
__device__ __forceinline__ void mlstm_chunk_scalars(int lane, int pn, int h, const float* __restrict__ LI, const float* __restrict__ LF,
                                                    float* __restrict__ bcum, float* __restrict__ kap, float* __restrict__ pmx, float* __restrict__ wexp, float* __restrict__ BT, float* __restrict__ MLOC) {
    float lfv[4], liv[4], b[4], kp[4], pm[4];
#pragma unroll
    for (int i = 0; i < 4; ++i) { const size_t tk = (size_t)pn * 256 + lane * 4 + i; liv[i] = LI[tk * 4 + h]; lfv[i] = LF[tk * 4 + h]; }
    b[0] = lfv[0]; b[1] = b[0] + lfv[1]; b[2] = b[1] + lfv[2]; b[3] = b[2] + lfv[3];
    float inc = b[3];
#pragma unroll
    for (int o = 1; o < 64; o <<= 1) { const float v = __uint_as_float((unsigned)__builtin_amdgcn_ds_bpermute(((lane - o) & 63) << 2, (int)__float_as_uint(inc))); if (lane >= o) inc += v; }
    const float excl = inc - b[3];
#pragma unroll
    for (int i = 0; i < 4; ++i) { b[i] += excl; kp[i] = liv[i] - b[i]; }
    pm[0] = kp[0]; pm[1] = fmaxf(pm[0], kp[1]); pm[2] = fmaxf(pm[1], kp[2]); pm[3] = fmaxf(pm[2], kp[3]);
    float pinc = pm[3];
#pragma unroll
    for (int o = 1; o < 64; o <<= 1) { const float v = __uint_as_float((unsigned)__builtin_amdgcn_ds_bpermute(((lane - o) & 63) << 2, (int)__float_as_uint(pinc))); if (lane >= o) pinc = fmaxf(pinc, v); }
    float pex = __uint_as_float((unsigned)__builtin_amdgcn_ds_bpermute(((lane - 1) & 63) << 2, (int)__float_as_uint(pinc))); if (lane == 0) pex = -INFINITY;
#pragma unroll
    for (int i = 0; i < 4; ++i) pm[i] = fmaxf(pm[i], pex);
    const float bT = __uint_as_float((unsigned)__builtin_amdgcn_readlane((int)__float_as_uint(b[3]), 63));
    const float ml = wave_max(fmaxf(fmaxf(bT + kp[0], bT + kp[1]), fmaxf(bT + kp[2], bT + kp[3])));
    const size_t o4 = (size_t)h * MH + (size_t)pn * 256 + lane * 4;
    *(f32x4*)(bcum + o4) = (f32x4){b[0], b[1], b[2], b[3]};
    *(f32x4*)(kap + o4) = (f32x4){kp[0], kp[1], kp[2], kp[3]};
    *(f32x4*)(pmx + o4) = (f32x4){pm[0], pm[1], pm[2], pm[3]};
    *(f32x4*)(wexp + o4) = (f32x4){__expf(bT + kp[0] - ml), __expf(bT + kp[1] - ml), __expf(bT + kp[2] - ml), __expf(bT + kp[3] - ml)};
    if (lane == 0) { BT[pn * 4 + h] = bT; MLOC[pn * 4 + h] = ml; }
}

__device__ __forceinline__ float mlstm_mc(const float* __restrict__ BT, const float* __restrict__ MLOC, int pn, int h) {
    unsigned ones_ = ~0u; asm volatile("" : "+s"(ones_));
    const int lid_ = (int)(__builtin_amdgcn_mbcnt_hi(ones_, __builtin_amdgcn_mbcnt_lo(ones_, 0u)));
    const int c = pn & 15, p0 = pn & ~15, l = lid_ & 15;
    const float bt = BT[(p0 + l) * 4 + h], ml = MLOC[(p0 + l) * 4 + h];
    float m = 0.f;
    for (int cc = 0; cc < c; ++cc) m = fmaxf(__uint_as_float((unsigned)__builtin_amdgcn_readlane((int)__float_as_uint(bt), cc)) + m, __uint_as_float((unsigned)__builtin_amdgcn_readlane((int)__float_as_uint(ml), cc)));
    return m;
}

__device__ __forceinline__ void mlstm_scan_items(int gtid, int nthreads, int iend, int cw_, int G_, int t_, bf16* __restrict__ CT, const float* __restrict__ BT, const float* __restrict__ MLOC, const float* __restrict__ DNP, float* __restrict__ NST) {
    asm volatile("" : "+v"(gtid));
    for (int item = gtid; item < iend; item += nthreads) {
        const int dk8 = item & 31, dv = (item >> 5) & 255, bh = item >> 13, bl = bh >> 2, h = bh & 3;
        bf16* p = CT + (((size_t)bl * 16 * 1024 + h * 256 + dv) * 256) + dk8 * 8;
        u32x4 d[16];
#pragma unroll
        for (int c = 0; c < 16; ++c) d[c] = *(const u32x4*)(p + (size_t)c * 1024 * 256);
        float btv[16], mlv[16];
#pragma unroll
        for (int c = 0; c < 16; ++c) { btv[c] = BT[((bl * 16 + c) * 4) + h]; mlv[c] = MLOC[((bl * 16 + c) * 4) + h]; }
        float s[8]; float m = 0.f;
#pragma unroll
        for (int k = 0; k < 8; ++k) s[k] = 0.f;
#pragma unroll
        for (int c = 0; c < 16; ++c) {
            u32x4 w; w.x = pk2(s[0], s[1]); w.y = pk2(s[2], s[3]); w.z = pk2(s[4], s[5]); w.w = pk2(s[6], s[7]);
            *(u32x4*)(p + (size_t)c * 1024 * 256) = w;
            const float bt = btv[c], ml = mlv[c];
            const float mn = fmaxf(bt + m, ml), dec = __expf(bt + m - mn), sc = __expf(ml - mn); m = mn;
            s[0] = dec * s[0] + sc * bflo(d[c].x); s[1] = dec * s[1] + sc * bfhi(d[c].x); s[2] = dec * s[2] + sc * bflo(d[c].y); s[3] = dec * s[3] + sc * bfhi(d[c].y);
            s[4] = dec * s[4] + sc * bflo(d[c].z); s[5] = dec * s[5] + sc * bfhi(d[c].z); s[6] = dec * s[6] + sc * bflo(d[c].w); s[7] = dec * s[7] + sc * bfhi(d[c].w);
        }
    }
    {
        const int per = (32 * 256 + G_ - 1) / G_;
        if (t_ < per) { const int item = cw_ * per + t_;
            if (item < 32 * 256) {
                const int dk = item & 255, bh = item >> 8, bl = bh >> 2, h = bh & 3;
                float dn[16], btv[16], mlv[16];
#pragma unroll
                for (int c = 0; c < 16; ++c) { const int U = (bl * 16 + c) * 4 + h;
                    dn[c] = (DNP[((size_t)U * 4 + 0) * 256 + dk] + DNP[((size_t)U * 4 + 1) * 256 + dk]) + (DNP[((size_t)U * 4 + 2) * 256 + dk] + DNP[((size_t)U * 4 + 3) * 256 + dk]);
                    btv[c] = BT[U]; mlv[c] = MLOC[U]; }
                float n = 0.f, m = 0.f;
#pragma unroll
                for (int c = 0; c < 16; ++c) { const int U = (bl * 16 + c) * 4 + h;
                    NST[(size_t)U * 256 + dk] = n;
                    const float mn = fmaxf(btv[c] + m, mlv[c]), dec = __expf(btv[c] + m - mn), sc = __expf(mlv[c] - mn); m = mn;
                    n = dec * n + sc * dn[c]; }
            } }
    }
}
__device__ __forceinline__ void mlstm_qn(float* qn, int G, int cwg, const bf16* __restrict__ Q, const float* __restrict__ NST, int wv0) {
    int tid_ = tidx(wv0); asm volatile("" : "+v"(tid_)); const int tid = tid_, row = tid >> 1, hf = tid & 1;
    for (int ui = 0; ui * G + cwg < NUNIT; ++ui) {
        const int U = ui * G + cwg, pn = U >> 2, h = U & 3;
        const bf16* qp = Q + ((size_t)pn * 256 + row) * 1024 + h * 256 + hf * 128; const float* np = NST + (size_t)U * 256 + hf * 128;
        float s = 0.f;
#pragma unroll
        for (int k = 0; k < 16; ++k) { const u32x4 w = *(const u32x4*)(qp + k * 8); const f32x4 n0 = *(const f32x4*)(np + k * 8), n1 = *(const f32x4*)(np + k * 8 + 4);
            s += (bflo(w.x) * n0.x + bfhi(w.x) * n0.y) + (bflo(w.y) * n0.z + bfhi(w.y) * n0.w) + (bflo(w.z) * n1.x + bfhi(w.z) * n1.y) + (bflo(w.w) * n1.z + bfhi(w.w) * n1.w); }
        s += dpp_f(s, DPP_XOR1);
        if (hf == 0) qn[ui * 256 + row] = s;
    }
    __syncthreads();
}
__host__ __device__ __forceinline__ int oddin_logical_col(int np) { const int tile = np >> 8, p = np & 255; return (tile < 5) ? tile * 256 + 64 * ((p >> 5) & 3) + 32 * (p >> 7) + (p & 31) : np; }

__device__ __forceinline__ void rope_table_items(int gtid, int nthreads, const int* __restrict__ positions, float* __restrict__ ROPE) {
    asm volatile("" : "+v"(gtid));
    for (int item = gtid; item < MTOK * 8; item += nthreads) {
        const int tok = item >> 3, i = item & 7;
        const double ang = (double)positions[tok] * exp(-13.122363377404328 * (double)i / 8.0);
        ROPE[(size_t)tok * 16 + i] = (float)cos(ang); ROPE[(size_t)tok * 16 + 8 + i] = (float)sin(ang);
    }
}
constexpr int AT_KP = 144, AT_VP = 528;
constexpr int AT_K_OFF = 0, AT_V_OFF = 256 * AT_KP, AT_P_OFF = AT_V_OFF + 64 * AT_VP, AT_LDS = AT_P_OFF + 8 * 16 * AT_VP;
static_assert(AT_LDS <= 147456, "attention LDS");
typedef short bf16x8_t __attribute__((ext_vector_type(8)));
__device__ __forceinline__ void attn_phase(unsigned char* lds, int G, int cwg, const bf16* __restrict__ QO, const bf16* __restrict__ KO, const bf16* __restrict__ VTG, const bf16* __restrict__ ZO,
                                           const float* __restrict__ sinks, bf16* __restrict__ ABUF, int wv0) {
    int tid_ = tidx(wv0); asm volatile("" : "+v"(tid_));
    const int tid = tid_, lane = tid & 63, wv = __builtin_amdgcn_readfirstlane(tid >> 6), l15 = lane & 15, kg = lane >> 4;
    unsigned char* Ks = lds + AT_K_OFF; unsigned char* Vs = lds + AT_V_OFF;
    u32x4 kreg[4], vreg[4];
    auto load_kv = [&](int U) {
        const int kvh = U & 3, j = (U >> 2) & 31, b = U >> 7; const size_t tok0 = (size_t)b * SEQ + 128 * j;
#pragma unroll
        for (int i = 0; i < 4; ++i) { const int p = tid + 512 * i, key = p >> 3, part = p & 7; const int keyc = (j > 0 || key >= 128) ? key : key + 128;
            kreg[i] = *(const u32x4*)(KO + (tok0 - 128 + keyc) * 256 + kvh * 64 + part * 8); }
#pragma unroll
        for (int i = 0; i < 4; ++i) { const int p = tid + 512 * i, dv = p >> 5, part = p & 31; const int partc = (j > 0 || part >= 16) ? part : part + 16;
            vreg[i] = *(const u32x4*)(VTG + (size_t)(kvh * 64 + dv) * MTOK + tok0 - 128 + partc * 8); }
    };
    bf16x8_t qn[4][2];
    auto load_q = [&](int U) {
        const int kvh = U & 3, j = (U >> 2) & 31, b = U >> 7; const size_t tok0 = (size_t)b * SEQ + 128 * j; const int head = kvh * 4 + (wv >> 1);
#pragma unroll
        for (int rb = 0; rb < 4; ++rb) { const bf16* qp = QO + (tok0 + (wv & 1) * 64 + rb * 16 + l15) * 1024 + head * 64 + kg * 8; qn[rb][0] = *(const bf16x8_t*)qp; qn[rb][1] = *(const bf16x8_t*)(qp + 32); }
    };
    auto perm = [&](int n) { if (G != 256) return n; const int i = n >> 8, c = n & 255, x = c & 7, r = c >> 3; return ((2 * x + (i >> 2)) << 7) | (r << 2) | (i & 3); };
    if (cwg < NB * 32 * 4) { const int U0 = perm(cwg); load_kv(U0); load_q(U0); }
    for (int n = cwg; n < NB * 32 * 4; n += G) {
        const int U = perm(n);
        const int kvh = U & 3, j = (U >> 2) & 31, b = U >> 7;
        const size_t tok0 = (size_t)b * SEQ + 128 * j;
        const int head = kvh * 4 + (wv >> 1);
        bf16x8_t qf[4][2];
#pragma unroll
        for (int rb = 0; rb < 4; ++rb) { qf[rb][0] = qn[rb][0]; qf[rb][1] = qn[rb][1]; }
        __syncthreads();
#pragma unroll
        for (int i = 0; i < 4; ++i) { const int p = tid + 512 * i, key = p >> 3, part = p & 7; u32x4 kv_ = kreg[i]; if (!(j > 0 || key >= 128)) { unsigned z0 = 0u; asm volatile("" : "+v"(z0)); kv_ = (u32x4){z0, z0, z0, z0}; } *(u32x4*)(Ks + key * AT_KP + part * 16) = kv_; }
#pragma unroll
        for (int i = 0; i < 4; ++i) { const int p = tid + 512 * i, dv = p >> 5, part = p & 31; u32x4 vv_ = vreg[i]; if (!(j > 0 || part >= 16)) { unsigned z0 = 0u; asm volatile("" : "+v"(z0)); vv_ = (u32x4){z0, z0, z0, z0}; } *(u32x4*)(Vs + dv * AT_VP + part * 16) = vv_; }
        __syncthreads();
        const float sink = sinks[head];
        { const int Un = perm((n + G < NB * 32 * 4) ? n + G : n); load_kv(Un); load_q(Un); }
#pragma unroll
        for (int rb = 0; rb < 4; ++rb) {
            const int qb16 = (wv & 1) * 4 + rb, qoff = qb16 * 16;
            u32x2 zw[4];
#pragma unroll
            for (int db = 0; db < 4; ++db) zw[db] = *(const u32x2*)(ZO + (tok0 + qoff + l15) * 1024 + head * 64 + 4 * kg + db * 16);
            pg8::f32x4 s[9];
            float mx = sink;
            {   bf16x8_t kf[5][2];
#pragma unroll
                for (int kk = 0; kk < 5; ++kk) { const unsigned char* kp = Ks + ((qb16 + kk) * 16 + l15) * AT_KP + kg * 16; kf[kk][0] = *(const bf16x8_t*)kp; kf[kk][1] = *(const bf16x8_t*)(kp + 64); }
#pragma unroll
                for (int kk = 0; kk < 5; ++kk) { s[kk] = __builtin_amdgcn_mfma_f32_16x16x32_bf16(kf[kk][0], qf[rb][0], (pg8::f32x4){0.f, 0.f, 0.f, 0.f}, 0, 0, 0); s[kk] = __builtin_amdgcn_mfma_f32_16x16x32_bf16(kf[kk][1], qf[rb][1], s[kk], 0, 0, 0); }
#pragma unroll
                for (int kk = 5; kk < 9; ++kk) { const unsigned char* kp = Ks + ((qb16 + kk) * 16 + l15) * AT_KP + kg * 16; kf[kk - 5][0] = *(const bf16x8_t*)kp; kf[kk - 5][1] = *(const bf16x8_t*)(kp + 64); }
#pragma unroll
                for (int kk = 5; kk < 9; ++kk) { s[kk] = __builtin_amdgcn_mfma_f32_16x16x32_bf16(kf[kk - 5][0], qf[rb][0], (pg8::f32x4){0.f, 0.f, 0.f, 0.f}, 0, 0, 0); s[kk] = __builtin_amdgcn_mfma_f32_16x16x32_bf16(kf[kk - 5][1], qf[rb][1], s[kk], 0, 0, 0); }
            }
#pragma unroll
            for (int kk = 0; kk < 9; ++kk) {
                const int kb = qb16 + kk; const bool have = (j > 0) || (kb >= 8);
#pragma unroll
                for (int r = 0; r < 4; ++r) { const int ii = 4 * kg + r;
                    const bool ok = have && (kk == 0 ? (ii > l15) : (kk == 8 ? (ii <= l15) : true));
                    const float v = ok ? s[kk][r] * 0.125f : -INFINITY; s[kk][r] = v; mx = fmaxf(mx, v); }
            }
            mx = max_x32(max_x16(mx));
            float sum = 0.f;
            unsigned pw[10][2];
#pragma unroll
            for (int kk = 0; kk < 9; ++kk) {
                float p[4];
#pragma unroll
                for (int r = 0; r < 4; ++r) { p[r] = __expf(s[kk][r] - mx); sum += p[r]; }
                pw[kk][0] = pk2(p[0], p[1]); pw[kk][1] = pk2(p[2], p[3]);
            }
            pw[9][0] = 0u; pw[9][1] = 0u;
            sum = sum_x32(sum_x16(sum));
            const float inv = 1.f / (sum + __expf(sink - mx));
            pg8::f32x4 o[4];
#pragma unroll
            for (int db = 0; db < 4; ++db) o[db] = (pg8::f32x4){0.f, 0.f, 0.f, 0.f};
#pragma unroll
            for (int t = 0; t < 5; ++t) {
                const u32x4 pu = (u32x4){pw[2 * t][0], pw[2 * t][1], pw[2 * t + 1][0], pw[2 * t + 1][1]};
                const bf16x8_t pf = __builtin_bit_cast(bf16x8_t, pu);
                const unsigned char* vb = Vs + l15 * AT_VP + ((qb16 + 2 * t) * 16 + 4 * kg) * 2;
#pragma unroll
                for (int db = 0; db < 4; ++db) {
                    const u32x2 v0 = *(const u32x2*)(vb + db * 16 * AT_VP);
                    u32x2 v1 = (u32x2){0u, 0u};
                    if (t < 4) v1 = *(const u32x2*)(vb + db * 16 * AT_VP + 32);
                    const u32x4 vu = (u32x4){v0.x, v0.y, v1.x, v1.y};
                    o[db] = __builtin_amdgcn_mfma_f32_16x16x32_bf16(__builtin_bit_cast(bf16x8_t, vu), pf, o[db], 0, 0, 0);
                }
            }
            const size_t orow = (tok0 + qoff + l15) * 1024 + head * 64 + 4 * kg;
#pragma unroll
            for (int db = 0; db < 4; ++db) {
                u32x2 w; w.x = pk2(o[db].x * inv * bflo(zw[db].x), o[db].y * inv * bfhi(zw[db].x)); w.y = pk2(o[db].z * inv * bflo(zw[db].y), o[db].w * inv * bfhi(zw[db].y));
                *(u32x2*)(ABUF + orow + db * 16) = w;
            }
        }
    }
}
#define WB(T, ws, off) ((T*)((ws) + (unsigned)(off)))
#define WB2(T, ws, cst, off) ((T*)(((ws) + (size_t)(cst)) + (unsigned)(off)))
typedef unsigned char* wsp_t;

struct SchedGrid {
    const char* ws; unsigned a_off, b_off, a_pm, b_pn;
    int nM, nN, lda, ldb, K, pad;
    __device__ __forceinline__ bool at(int L, pg8::Unit& u) const {
        const int nwg = nM * nN; if (L >= nwg) return false;
        int wgid = L; { const int q = nwg / 8, r = nwg % 8, xcd = wgid % 8, off = wgid / 8; wgid = (xcd < r ? xcd * (q + 1) : r * (q + 1) + (xcd - r) * q) + off; }
        const int nig = 8 * nN, gid = wgid / nig, fm = gid * 8, gsz = (nM - fm) < 8 ? (nM - fm) : 8;
        u.pm = fm + ((wgid % nig) % gsz); u.pn = (wgid % nig) / gsz; u.z = 0; u.flags = pg8::UF_ZERO | pg8::UF_EPI; u.lda = lda; u.ldb = ldb; u.K = K; u.kind = 0;
        u.A = ws + (a_off + (unsigned)u.pm * a_pm); u.B = ws + (b_off + (unsigned)u.pn * b_pn); return true;
    }
};
struct SchedEvenIn {
    SchedGrid g;
    __device__ __forceinline__ bool at(int L, pg8::Unit& u) const {
        if (!g.at(L, u)) return false;
        if (u.pn >= 8) { u.pn ^= 4; u.B = g.ws + (g.b_off + (unsigned)u.pn * g.b_pn); }
        return true;
    }
};
struct FEvenIn2 {
    static constexpr int NV = 16;
    wsp_t ws;
    __device__ __forceinline__ void operator()(const pg8::Unit& u, int r, int c, f32x4 lo, f32x4 hi) const {
        const unsigned sec = u.pn >> 2, cs = (u.pn & 3) * 256 + c, rl = u.pm * 256 + r;
        if (sec & 1) { lo.x = silu_f(lo.x); lo.y = silu_f(lo.y); lo.z = silu_f(lo.z); lo.w = silu_f(lo.w); hi.x = silu_f(hi.x); hi.y = silu_f(hi.y); hi.z = silu_f(hi.z); hi.w = silu_f(hi.w); }
        u32x4 w; w.x = pk2(lo.x, lo.y); w.y = pk2(lo.z, lo.w); w.z = pk2(hi.x, hi.y); w.w = pk2(hi.z, hi.w);
        if (sec == 0) { const unsigned g = cs >> 4, q0 = cs & 15, bl = rl >> 12, t = rl & 4095;
            *WB2(u32x4, ws, w2::AU, ((g * S5ROWS + bl * 256 + (t >> 4)) * AUP + (t & 15) * 16 + q0) * 2) = w; }
        else *WB2(u32x4, ws, w2::ZS, (sec - 1) * (64u << 20) + (rl * 1024 + cs) * 2) = w;
    }
};
struct SchedS5 {
    const char* ws; unsigned b_off, b_g; int ldb, K;
    __device__ __forceinline__ bool at(int L, pg8::Unit& u) const {
        if (L >= 64 * 8) return false;
        u.z = L >> 3; u.pm = L & 7; u.pn = 0; u.flags = pg8::UF_ZERO | pg8::UF_EPI; u.lda = AUP; u.ldb = ldb; u.K = K; u.kind = 0;
        u.A = ws + (unsigned)(w2::AU + ((unsigned)u.z * S5ROWS + u.pm * 256) * AUP * 2); u.B = ws + (b_off + (unsigned)u.z * b_g); return true;
    }
};
struct FS5Z {
    static constexpr int NV = 0;
    wsp_t ws;
    __device__ __forceinline__ void operator()(const pg8::Unit& u, int r, int c, f32x4 lo, f32x4 hi) const {
        if (c < 128) { u32x4 w; w.x = pk2(lo.x, lo.y); w.y = pk2(lo.z, lo.w); w.z = pk2(hi.x, hi.y); w.w = pk2(hi.z, hi.w);
            *WB2(u32x4, ws, w2::ZINC, (((unsigned)u.z * S5ROWS + u.pm * 256 + r) * 128 + c) * 2) = w; }
    }
};
struct EpiS5Y {
    static constexpr int NV = 16;
    static constexpr bool PERM = true;
    wsp_t ws;
    __device__ __forceinline__ void mid(pg8::f32x4 (&)[2][2][4][2], const pg8::Unit&, int, int, int, int) const {}
    __device__ __forceinline__ void operator()(const pg8::f32x4 (&acc)[2][2][4][2], const pg8::Unit& u, int wr, int wc, int fr, int fq) const {
        const unsigned g = u.z;
#pragma unroll
        for (int ai = 0; ai < 2; ++ai)
#pragma unroll
            for (int m = 0; m < 4; ++m) {
                const unsigned row = (unsigned)u.pm * 256 + ai * 128 + wr * 64 + m * 16 + fr, bl = row >> 8, chunk = row & 255;
#pragma unroll
                for (int bj = 0; bj < 2; ++bj) {
                    const unsigned c = bj * 128 + wc * 32 + 8 * fq, j = c >> 4, p0 = c & 15;
                    const f32x4 lo = acc[ai][bj][m][0], hi = acc[ai][bj][m][1];
                    u32x4 w;
                    w.x = pk2(gelu_tanh_f(lo.x), gelu_tanh_f(lo.y)); w.y = pk2(gelu_tanh_f(lo.z), gelu_tanh_f(lo.w)); w.z = pk2(gelu_tanh_f(hi.x), gelu_tanh_f(hi.y)); w.w = pk2(gelu_tanh_f(hi.z), gelu_tanh_f(hi.w));
                    const unsigned tok = bl * SEQ + chunk * S5T + j;
                    *WB2(u32x4, ws, w2::Z, (tok * 1024 + g * 16 + p0) * 2) = w;
                }
            }
    }
};
struct EpiGlu {
    static constexpr int NV = 16;
    static constexpr bool PERM = true;
    wsp_t ws;
    __device__ __forceinline__ void mid(pg8::f32x4 (&)[2][2][4][2], const pg8::Unit&, int, int, int, int) const {}
    __device__ __forceinline__ void operator()(const pg8::f32x4 (&acc)[2][2][4][2], const pg8::Unit& u, int wr, int wc, int fr, int fq) const {
#pragma unroll
        for (int ai = 0; ai < 2; ++ai) {
            u32x4 yw[4][2], zw[4][2];
#pragma unroll
            for (int m = 0; m < 4; ++m)
#pragma unroll
                for (int bj = 0; bj < 2; ++bj) { const unsigned o = (((unsigned)u.pm * 256 + ai * 128 + wr * 64 + m * 16 + fr) * 1024 + u.pn * 256 + bj * 128 + wc * 32 + 8 * fq) * 2;
                    yw[m][bj] = *WB2(const u32x4, ws, w2::Z, o); zw[m][bj] = *WB2(const u32x4, ws, w2::ZS, o); }
#pragma unroll
            for (int m = 0; m < 4; ++m)
#pragma unroll
                for (int bj = 0; bj < 2; ++bj) { const unsigned o = (((unsigned)u.pm * 256 + ai * 128 + wr * 64 + m * 16 + fr) * 1024 + u.pn * 256 + bj * 128 + wc * 32 + 8 * fq) * 2;
                    const f32x4 lo = acc[ai][bj][m][0], hi = acc[ai][bj][m][1]; const u32x4 y = yw[m][bj], z = zw[m][bj];
                    u32x4 w;
                    w.x = pk2(bflo(y.x) * sigmoid_f(lo.x) * bflo(z.x), bfhi(y.x) * sigmoid_f(lo.y) * bfhi(z.x));
                    w.y = pk2(bflo(y.y) * sigmoid_f(lo.z) * bflo(z.y), bfhi(y.y) * sigmoid_f(lo.w) * bfhi(z.y));
                    w.z = pk2(bflo(y.z) * sigmoid_f(hi.x) * bflo(z.z), bfhi(y.z) * sigmoid_f(hi.y) * bfhi(z.z));
                    w.w = pk2(bflo(y.w) * sigmoid_f(hi.z) * bflo(z.w), bfhi(y.w) * sigmoid_f(hi.w) * bfhi(z.w));
                    *WB2(u32x4, ws, w2::HN, o) = w; }
        }
    }
};
struct EpiResidH {
    static constexpr int NV = 16;
    static constexpr bool PERM = true;
    const bf16* hsrc; void* dst; wsp_t ws; unsigned goff; int row0, dst_f32;
    __device__ __forceinline__ void mid(pg8::f32x4 (&)[2][2][4][2], const pg8::Unit&, int, int, int, int) const {}
    __device__ __forceinline__ void operator()(const pg8::f32x4 (&acc)[2][2][4][2], const pg8::Unit& u, int wr, int wc, int fr, int fq) const {
        const unsigned b = ((unsigned)row0 + u.pm * 256) >> 12;
        f32x4 gt[2][2];
#pragma unroll
        for (int bj = 0; bj < 2; ++bj)
#pragma unroll
            for (int n = 0; n < 2; ++n) gt[bj][n] = *WB(const f32x4, ws, goff + (b * 3072 + u.pn * 256 + bj * 128 + wc * 32 + 8 * fq + 4 * n) * 4);
#pragma unroll
        for (int ai = 0; ai < 2; ++ai) {
            u32x4 hv[4][2];
#pragma unroll
            for (int m = 0; m < 4; ++m)
#pragma unroll
                for (int bj = 0; bj < 2; ++bj) hv[m][bj] = *(const u32x4*)(hsrc + (size_t)((unsigned)row0 + u.pm * 256 + ai * 128 + wr * 64 + m * 16 + fr) * 1024 + u.pn * 256 + bj * 128 + wc * 32 + 8 * fq);
            if (dst_f32) {
#pragma unroll
                for (int m = 0; m < 4; ++m)
#pragma unroll
                    for (int bj = 0; bj < 2; ++bj) {
                        const u32x4 w = hv[m][bj]; const f32x4 a0 = acc[ai][bj][m][0], a1 = acc[ai][bj][m][1], g0 = gt[bj][0], g1 = gt[bj][1];
                        f32x4 lo, hi;
                        lo.x = bflo(w.x) + g0.x * a0.x; lo.y = bfhi(w.x) + g0.y * a0.y; lo.z = bflo(w.y) + g0.z * a0.z; lo.w = bfhi(w.y) + g0.w * a0.w;
                        hi.x = bflo(w.z) + g1.x * a1.x; hi.y = bfhi(w.z) + g1.y * a1.y; hi.z = bflo(w.w) + g1.z * a1.z; hi.w = bfhi(w.w) + g1.w * a1.w;
                        float* o = (float*)dst + (size_t)((unsigned)row0 + u.pm * 256 + ai * 128 + wr * 64 + m * 16 + fr) * 1024 + u.pn * 256 + bj * 128 + wc * 32 + 8 * fq;
                        *(f32x4*)o = lo; *(f32x4*)(o + 4) = hi;
                    }
            } else {
#pragma unroll
                for (int m = 0; m < 4; ++m)
#pragma unroll
                    for (int bj = 0; bj < 2; ++bj) {
                        const u32x4 w = hv[m][bj]; const f32x4 a0 = acc[ai][bj][m][0], a1 = acc[ai][bj][m][1], g0 = gt[bj][0], g1 = gt[bj][1];
                        u32x4 r;
                        r.x = pk2(bflo(w.x) + g0.x * a0.x, bfhi(w.x) + g0.y * a0.y); r.y = pk2(bflo(w.y) + g0.z * a0.z, bfhi(w.y) + g0.w * a0.w);
                        r.z = pk2(bflo(w.z) + g1.x * a1.x, bfhi(w.z) + g1.y * a1.y); r.w = pk2(bflo(w.w) + g1.z * a1.z, bfhi(w.w) + g1.w * a1.w);
                        *(u32x4*)((bf16*)dst + (size_t)((unsigned)row0 + u.pm * 256 + ai * 128 + wr * 64 + m * 16 + fr) * 1024 + u.pn * 256 + bj * 128 + wc * 32 + 8 * fq) = r;
                    }
            }
        }
    }
};
struct SchedQKO {
    const char* ws; unsigned w_off;
    __device__ __forceinline__ bool at(int L, pg8::Unit& u) const {
        if (L >= 2 * NUNIT) return false;
        const int t = L >> 3, j = L & 7, z = (j >> 2) * 2; u.z = z; u.pm = t; u.pn = j & 3; u.flags = pg8::UF_ZERO | pg8::UF_EPI; u.lda = 1024; u.ldb = 256; u.K = 256; u.kind = 0;
        u.A = ws + (unsigned)((z == 2 ? w2::MIN : w2::XC) + ((unsigned)u.pm * 256 * 1024 + u.pn * 256) * 2); u.B = ws + (w_off + ((unsigned)((z * (z + 1)) >> 1) << 20) + (unsigned)u.pn * 65536 * 2); return true;
    }
};
struct FQKO {
    static constexpr int NV = 0;
    wsp_t ws;
    __device__ __forceinline__ void operator()(const pg8::Unit& u, int r, int c, f32x4 lo, f32x4 hi) const {
        if (u.z == 2) { lo.x = sigmoid_f(lo.x); lo.y = sigmoid_f(lo.y); lo.z = sigmoid_f(lo.z); lo.w = sigmoid_f(lo.w); hi.x = sigmoid_f(hi.x); hi.y = sigmoid_f(hi.y); hi.z = sigmoid_f(hi.z); hi.w = sigmoid_f(hi.w); }
        u32x4 w; w.x = pk2(lo.x, lo.y); w.y = pk2(lo.z, lo.w); w.z = pk2(hi.x, hi.y); w.w = pk2(hi.z, hi.w);
        *WB2(u32x4, ws, w2::Q, (unsigned)u.z * (64u << 20) + (((unsigned)u.pm * 256 + r) * 1024 + u.pn * 256 + c) * 2) = w;
    }
};
struct EpiXO {
    static constexpr int NV = 0;
    static constexpr bool PERM = true;
    pg8::Epi8<FQKO> base; PG8_LAS float* qnp;
    __device__ __forceinline__ void mid(pg8::f32x4 (&)[2][2][4][2], const pg8::Unit&, int, int, int, int) const {}
    __device__ __forceinline__ void operator()(const pg8::f32x4 (&acc)[2][2][4][2], const pg8::Unit& u, int wr, int wc, int fr, int fq) const {
        base(acc, u, wr, wc, fr, fq);
        if (u.z == 0) {
            f32x4 nv[2][2];
#pragma unroll
            for (int bj = 0; bj < 2; ++bj)
#pragma unroll
                for (int n = 0; n < 2; ++n) nv[bj][n] = *WB2(const f32x4, base.f.ws, w2::NST, ((((unsigned)u.pm << 2) + u.pn) * 256 + bj * 128 + wc * 32 + 8 * fq + 4 * n) * 4);
#pragma unroll
            for (int ai = 0; ai < 2; ++ai)
#pragma unroll
                for (int m = 0; m < 4; ++m) {
                    const unsigned r = ai * 128 + wr * 64 + m * 16 + fr; float ps = 0.f;
#pragma unroll
                    for (int bj = 0; bj < 2; ++bj) {
                        const f32x4 lo = acc[ai][bj][m][0], hi = acc[ai][bj][m][1];
                        ps += ((lo.x * nv[bj][0].x + lo.y * nv[bj][0].y) + (lo.z * nv[bj][0].z + lo.w * nv[bj][0].w)) + ((hi.x * nv[bj][1].x + hi.y * nv[bj][1].y) + (hi.z * nv[bj][1].z + hi.w * nv[bj][1].w));
                    }
                    ps = sum_x32(sum_x16(ps));
                    if (fq == 0) qnp[((unsigned)u.kind * 256 + r) * 4 + wc] = ps;
                }
        }
    }
};
struct SchedKV {
    const char* ws; unsigned w_off;
    __device__ __forceinline__ bool at(int L, pg8::Unit& u) const {
        if (L >= 2 * NUNIT) return false;
        const int t = L >> 3, j = L & 7, z = j >> 2; u.z = z; u.pn = t; u.pm = j & 3; u.flags = pg8::UF_ZERO | pg8::UF_EPI; u.lda = 256; u.ldb = 1024; u.K = 256; u.kind = 0;
        u.A = ws + (w_off + ((unsigned)z << 20) + (unsigned)u.pm * 65536 * 2); u.B = ws + (unsigned)((z == 0 ? w2::XC : w2::MIN) + ((unsigned)u.pn * 256 * 1024 + u.pm * 256) * 2); return true;
    }
};
__device__ __forceinline__ int isl_unit(int U) { if (gridDim.x != 256) return U; const int ui = U >> 8, c = U & 255, x = c & 7, r = c >> 3; return ((16 * x + 8 * ui + (r >> 2)) << 2) | (r & 3); }
struct SchedProj {
    SchedKV s1; int G, c, pair;
    static __device__ __forceinline__ int kv_index(int Lp, int pair) {
        if (!pair) return Lp;
        const int j = Lp >> 8, p = isl_unit((j >> 1) * 256 + (Lp & 255)); return 8 * (p >> 2) + 4 * (j & 1) + (p & 3);
    }
    __device__ __forceinline__ bool next(int i, pg8::Unit& u) const { const int L = i * G + c; if (L >= 2 * NUNIT) return false; return s1.at(kv_index(L, pair), u); }
};
struct SchedQO {
    SchedQKO s0; int G, c;
    __device__ __forceinline__ bool next(int i, pg8::Unit& u) const {
        const bool hot = (G == 256); if (hot && i >= 4) return false; const int ui = hot ? (((i + 1) >> 1) & 1) : (i >> 1), zs = hot ? (i < 2 ? 1 : 0) : (i & 1);
        const int U0 = ui * G + c; if (U0 >= NUNIT) return false; const int U = isl_unit(U0); const bool ok = s0.at(8 * (U >> 2) + 4 * zs + (U & 3), u); u.kind = ui; return ok; }
};
struct EpiKV {
    static constexpr int NV = 0;
    static constexpr bool PERM = true;
    wsp_t ws;
    __device__ __forceinline__ void mid(pg8::f32x4 (&)[2][2][4][2], const pg8::Unit&, int, int, int, int) const {}
    __device__ __forceinline__ void operator()(const pg8::f32x4 (&acc)[2][2][4][2], const pg8::Unit& u, int wr, int wc, int fr, int fq) const {
        const unsigned h = u.pm, dbase = w2::KWT + (unsigned)u.z * (64u << 20);
        f32x4 wx[2][2];
#pragma unroll
        for (int bj = 0; bj < 2; ++bj)
#pragma unroll
            for (int n = 0; n < 2; ++n) wx[bj][n] = (u.z == 0) ? *WB2(const f32x4, ws, w2::WEXP, (h * MH + (unsigned)u.pn * 256 + bj * 128 + wc * 32 + 8 * fq + 4 * n) * 4) : (f32x4){1.f, 1.f, 1.f, 1.f};
#pragma unroll
        for (int ai = 0; ai < 2; ++ai)
#pragma unroll
            for (int m = 0; m < 4; ++m) {
                const unsigned r = ai * 128 + wr * 64 + m * 16 + fr; float psum = 0.f;
#pragma unroll
                for (int bj = 0; bj < 2; ++bj) {
                    const unsigned c = bj * 128 + wc * 32 + 8 * fq;
                    const f32x4 lo = acc[ai][bj][m][0] * wx[bj][0], hi = acc[ai][bj][m][1] * wx[bj][1];
                    psum += ((lo.x + lo.y) + (lo.z + lo.w)) + ((hi.x + hi.y) + (hi.z + hi.w));
                    u32x4 w; w.x = pk2(lo.x, lo.y); w.y = pk2(lo.z, lo.w); w.z = pk2(hi.x, hi.y); w.w = pk2(hi.z, hi.w);
                    *WB(u32x4, ws, dbase + ((((unsigned)u.pn * 1024 + h * 256 + r) * 256) + c) * 2) = w;
                }
                if (u.z == 0) { psum = sum_x32(sum_x16(psum)); if (fq == 0) *WB2(float, ws, w2::DNP, ((((unsigned)u.pn * 4 + h) * 4 + wc) * 256 + r) * 4) = psum; }
            }
    }
};
struct SchedDC {
    const char* ws;
    __device__ __forceinline__ bool at(int U0, pg8::Unit& u) const {
        if (U0 >= NUNIT) return false;
        const int U = isl_unit(gridDim.x == 256 ? (U0 ^ 256) : U0);
        u.pn = U >> 2; u.pm = U & 3; u.z = 0; u.flags = pg8::UF_ZERO | pg8::UF_EPI; u.lda = 256; u.ldb = 256; u.K = 256; u.kind = 0;
        const unsigned off = (((unsigned)u.pn * 1024 + u.pm * 256) * 256) * 2; u.A = ws + (unsigned)(w2::VT + off); u.B = ws + (unsigned)(w2::KWT + off); return true;
    }
};
struct FDC {
    static constexpr int NV = 16;
    wsp_t ws;
    __device__ __forceinline__ void operator()(const pg8::Unit& u, int r, int c, f32x4 lo, f32x4 hi) const {
        u32x4 w; w.x = pk2(lo.x, lo.y); w.y = pk2(lo.z, lo.w); w.z = pk2(hi.x, hi.y); w.w = pk2(hi.z, hi.w);
        *WB2(u32x4, ws, w2::CT, ((((unsigned)u.pn * 1024 + u.pm * 256 + r) * 256) + c) * 2) = w;
    }
};
struct SchedS {
    const char* ws;
    __device__ __forceinline__ bool at(int U0, pg8::Unit& u) const {
        if (U0 >= NUNIT) return false;
        const int U = isl_unit(U0);
        u.pn = U >> 2; u.pm = U & 3; u.z = 0; u.flags = pg8::UF_ZERO | pg8::UF_EPI; u.lda = 1024; u.ldb = 1024; u.K = 256; u.kind = 0;
        const unsigned off = ((unsigned)u.pn * 256 * 1024 + u.pm * 256) * 2; u.A = ws + (unsigned)(w2::Q + off); u.B = ws + (unsigned)(w2::XC + off); return true;
    }
};
struct EpiS {
    static constexpr int NV = 0;
    static constexpr bool PERM = true;
    wsp_t ws;
    __device__ __forceinline__ void mid(pg8::f32x4 (&)[2][2][4][2], const pg8::Unit&, int, int, int, int) const {}
    __device__ __forceinline__ void operator()(const pg8::f32x4 (&acc)[2][2][4][2], const pg8::Unit& u, int wr, int wc, int fr, int fq) const {
        const unsigned h = u.pm;
        f32x4 kp[2][2]; float pmv[2][4];
#pragma unroll
        for (int bj = 0; bj < 2; ++bj)
#pragma unroll
            for (int n = 0; n < 2; ++n) kp[bj][n] = *WB2(const f32x4, ws, w2::KAP, (h * MH + (unsigned)u.pn * 256 + bj * 128 + wc * 32 + 8 * fq + 4 * n) * 4);
#pragma unroll
        for (int ai = 0; ai < 2; ++ai)
#pragma unroll
            for (int m = 0; m < 4; ++m) pmv[ai][m] = *WB2(const float, ws, w2::PMX, (h * MH + (unsigned)u.pn * 256 + ai * 128 + wr * 64 + m * 16 + fr) * 4);
        const float mc = mlstm_mc(WB2(const float, ws, w2::BT, 0), WB2(const float, ws, w2::MLOC, 0), u.pn, h);
#pragma unroll
        for (int ai = 0; ai < 2; ++ai)
#pragma unroll
            for (int m = 0; m < 4; ++m) {
                const unsigned r = ai * 128 + wr * 64 + m * 16 + fr, tokj = (unsigned)u.pn * 256 + r;
                const float rho = fmaxf(mc, pmv[ai][m]); float psum = 0.f;
#pragma unroll
                for (int bj = 0; bj < 2; ++bj) {
                    const unsigned c = bj * 128 + wc * 32 + 8 * fq;
                    const f32x4 k0 = kp[bj][0], k1 = kp[bj][1];
                    const f32x4 lo = acc[ai][bj][m][0], hi = acc[ai][bj][m][1];
                    float p[8];
                    p[0] = (c + 0 <= r) ? lo.x * __expf(k0.x - rho) : 0.f; p[1] = (c + 1 <= r) ? lo.y * __expf(k0.y - rho) : 0.f;
                    p[2] = (c + 2 <= r) ? lo.z * __expf(k0.z - rho) : 0.f; p[3] = (c + 3 <= r) ? lo.w * __expf(k0.w - rho) : 0.f;
                    p[4] = (c + 4 <= r) ? hi.x * __expf(k1.x - rho) : 0.f; p[5] = (c + 5 <= r) ? hi.y * __expf(k1.y - rho) : 0.f;
                    p[6] = (c + 6 <= r) ? hi.z * __expf(k1.z - rho) : 0.f; p[7] = (c + 7 <= r) ? hi.w * __expf(k1.w - rho) : 0.f;
                    psum += ((p[0] + p[1]) + (p[2] + p[3])) + ((p[4] + p[5]) + (p[6] + p[7]));
                    u32x4 w; w.x = pk2(p[0], p[1]); w.y = pk2(p[2], p[3]); w.z = pk2(p[4], p[5]); w.w = pk2(p[6], p[7]);
                    *WB2(u32x4, ws, w2::MIN, (tokj * 1024 + h * 256 + c) * 2) = w;
                }
                psum = sum_x32(sum_x16(psum));
                if (fq == 0) *WB2(float, ws, w2::DSP, ((tokj * 4 + h) * 4 + wc) * 4) = psum;
            }
    }
};
struct SchedQP {
    const char* ws; int G, c;
    __device__ __forceinline__ bool next(int i, pg8::Unit& u) const {
        if (G == 256 && i >= 4) return false;
        const int ui = (G == 256) ? ((i >> 1) ^ 1) : (i >> 1), seg = i & 1, U0 = ui * G + c; if (U0 >= NUNIT) return false; const int U = isl_unit(U0);
        u.pn = U >> 2; u.pm = U & 3; u.z = ui; u.lda = 1024; u.ldb = 256; u.K = 256; u.kind = 0;
        const unsigned ao = ((unsigned)u.pn * 256 * 1024 + u.pm * 256) * 2, bo = (((unsigned)u.pn * 1024 + u.pm * 256) * 256) * 2;
        u.A = ws + (unsigned)((seg ? w2::MIN : w2::Q) + ao); u.B = ws + (unsigned)((seg ? w2::VT : w2::CT) + bo); u.flags = seg ? pg8::UF_EPI : (pg8::UF_ZERO | pg8::UF_MID);
        return true;
    }
};
struct EpiQP {
    static constexpr int NV = 0;
    static constexpr bool PERM = true;
    wsp_t ws; const float* ng; const float* skip; PG8_LAS float* qn; PG8_LAS float* xs;
    __device__ __forceinline__ void mid(pg8::f32x4 (&acc)[2][2][4][2], const pg8::Unit& u, int wr, int wc, int fr, int fq) const {
        const unsigned h = u.pm; float pmv[2][4];
#pragma unroll
        for (int ai = 0; ai < 2; ++ai)
#pragma unroll
            for (int m = 0; m < 4; ++m) pmv[ai][m] = *WB2(const float, ws, w2::PMX, (h * MH + (unsigned)u.pn * 256 + ai * 128 + wr * 64 + m * 16 + fr) * 4);
        const float mc = mlstm_mc(WB2(const float, ws, w2::BT, 0), WB2(const float, ws, w2::MLOC, 0), u.pn, h);
        if (fr + fq == 0) qn[2048 + wr * 4 + wc] = mc;
#pragma unroll
        for (int ai = 0; ai < 2; ++ai)
#pragma unroll
            for (int m = 0; m < 4; ++m) {
                const float g = __expf(mc - fmaxf(mc, pmv[ai][m]));
#pragma unroll
                for (int bj = 0; bj < 2; ++bj) { acc[ai][bj][m][0] = acc[ai][bj][m][0] * g; acc[ai][bj][m][1] = acc[ai][bj][m][1] * g; }
            }
    }
    __device__ __forceinline__ void operator()(pg8::f32x4 (&acc)[2][2][4][2], const pg8::Unit& u, int wr, int wc, int fr, int fq) const {
        const unsigned h = u.pm; const float mc = qn[2048 + wr * 4 + wc];
#pragma unroll
        for (int ai = 0; ai < 2; ++ai)
#pragma unroll
        for (int mh = 0; mh < 4; mh += 2) {
            float pmv[4], bcv[4]; f32x4 dsv[4]; u32x4 owv[4][2];
#pragma unroll
            for (int m = mh; m < mh + 2; ++m) { const unsigned tokj = (unsigned)u.pn * 256 + ai * 128 + wr * 64 + m * 16 + fr;
                pmv[m] = *WB2(const float, ws, w2::PMX, (h * MH + tokj) * 4); bcv[m] = *WB2(const float, ws, w2::BCUM, (h * MH + tokj) * 4); dsv[m] = *WB2(const f32x4, ws, w2::DSP, ((tokj * 4 + h) * 4) * 4);
#pragma unroll
                for (int bj = 0; bj < 2; ++bj) owv[m][bj] = *WB2(const u32x4, ws, w2::O, (tokj * 1024 + h * 256 + bj * 128 + wc * 32 + 8 * fq) * 2); }
#pragma unroll
            for (int m = mh; m < mh + 2; ++m) {
                const unsigned r = ai * 128 + wr * 64 + m * 16 + fr;
                const float rho = fmaxf(mc, pmv[m]), g = __expf(mc - rho);
                const f32x4 qn4 = *(const PG8_LAS f32x4*)(qn + (u.z * 256 + r) * 4);
                const float den = ((dsv[m].x + dsv[m].y) + (dsv[m].z + dsv[m].w)) + g * ((qn4.x + qn4.y) + (qn4.z + qn4.w));
                const float inv = 1.f / fmaxf(fabsf(den), __expf(-(bcv[m] + rho)));
                float ss = 0.f;
#pragma unroll
                for (int bj = 0; bj < 2; ++bj) {
                    const u32x4 ow = owv[m][bj];
                    f32x4 lo = acc[ai][bj][m][0] * inv, hi = acc[ai][bj][m][1] * inv;
                    lo.x *= bflo(ow.x); lo.y *= bfhi(ow.x); lo.z *= bflo(ow.y); lo.w *= bfhi(ow.y); hi.x *= bflo(ow.z); hi.y *= bfhi(ow.z); hi.z *= bflo(ow.w); hi.w *= bfhi(ow.w);
                    ss += ((lo.x * lo.x + lo.y * lo.y) + (lo.z * lo.z + lo.w * lo.w)) + ((hi.x * hi.x + hi.y * hi.y) + (hi.z * hi.z + hi.w * hi.w));
                    acc[ai][bj][m][0] = lo; acc[ai][bj][m][1] = hi;
                }
                ss = sum_x32(sum_x16(ss));
                if (fq == 0) xs[r * 4 + wc] = ss;
            }
        }
        f32x4 gv[2][2], sv[2][2];
#pragma unroll
        for (int bj = 0; bj < 2; ++bj)
#pragma unroll
            for (int n = 0; n < 2; ++n) { const unsigned hc = h * 256 + bj * 128 + wc * 32 + 8 * fq + 4 * n; gv[bj][n] = *(const f32x4*)(ng + hc); sv[bj][n] = *(const f32x4*)(skip + hc); }
        asm volatile("s_waitcnt lgkmcnt(0)" ::: "memory"); __builtin_amdgcn_s_barrier(); asm volatile("" ::: "memory");
#pragma unroll
        for (int ai = 0; ai < 2; ++ai)
#pragma unroll
        for (int mh = 0; mh < 4; mh += 2) {
            u32x4 xwv[4][2], zwv[4][2]; f32x4 x4v[4];
#pragma unroll
            for (int m = mh; m < mh + 2; ++m) { const unsigned r = ai * 128 + wr * 64 + m * 16 + fr, tokj = (unsigned)u.pn * 256 + r;
                x4v[m] = *(const PG8_LAS f32x4*)(xs + r * 4);
#pragma unroll
                for (int bj = 0; bj < 2; ++bj) { const unsigned o = (tokj * 1024 + h * 256 + bj * 128 + wc * 32 + 8 * fq) * 2; xwv[m][bj] = *WB2(const u32x4, ws, w2::XC, o); zwv[m][bj] = *WB2(const u32x4, ws, w2::MZS, o); } }
#pragma unroll
            for (int m = mh; m < mh + 2; ++m) {
                const unsigned r = ai * 128 + wr * 64 + m * 16 + fr, tokj = (unsigned)u.pn * 256 + r;
                const float rstd = rsqrtf(((x4v[m].x + x4v[m].y) + (x4v[m].z + x4v[m].w)) * (1.f / 256.f) + EPS);
#pragma unroll
                for (int bj = 0; bj < 2; ++bj) {
                    const unsigned hc = h * 256 + bj * 128 + wc * 32 + 8 * fq;
                    const u32x4 xw = xwv[m][bj], zw = zwv[m][bj]; const f32x4 g0 = gv[bj][0], g1 = gv[bj][1], s0 = sv[bj][0], s1 = sv[bj][1];
                    const f32x4 lo = acc[ai][bj][m][0], hi = acc[ai][bj][m][1];
                    u32x4 w;
                    w.x = pk2((lo.x * rstd * g0.x + s0.x * bflo(xw.x)) * bflo(zw.x), (lo.y * rstd * g0.y + s0.y * bfhi(xw.x)) * bfhi(zw.x));
                    w.y = pk2((lo.z * rstd * g0.z + s0.z * bflo(xw.y)) * bflo(zw.y), (lo.w * rstd * g0.w + s0.w * bfhi(xw.y)) * bfhi(zw.y));
                    w.z = pk2((hi.x * rstd * g1.x + s1.x * bflo(xw.z)) * bflo(zw.z), (hi.y * rstd * g1.y + s1.y * bfhi(xw.z)) * bfhi(zw.z));
                    w.w = pk2((hi.z * rstd * g1.z + s1.z * bflo(xw.w)) * bflo(zw.w), (hi.w * rstd * g1.w + s1.w * bfhi(xw.w)) * bfhi(zw.w));
                    *WB2(u32x4, ws, w2::KWT, (tokj * 1024 + hc) * 2) = w;
                }
            }
        }
    }
};
struct SchedOut2 {
    const char* ws; unsigned b_off; int G, c;
    __device__ __forceinline__ bool next(int i, pg8::Unit& u) const {
        const int ui = i >> 1, seg = i & 1; const int nM = NTILE, nN = 4, nwg = nM * nN; if (ui * G + c >= nwg) return false;
        const bool hot = (G == 256); const int L = (hot ? (ui ^ 1) : ui) * G + c; const int sg = hot ? (seg ^ 1) : seg;
        int wgid = L; { const int q = nwg / 8, r = nwg % 8, xcd = wgid % 8, off = wgid / 8; wgid = (xcd < r ? xcd * (q + 1) : r * (q + 1) + (xcd - r) * q) + off; }
        const int nig = 8 * nN, gid = wgid / nig, fm = gid * 8, gsz = (nM - fm) < 8 ? (nM - fm) : 8;
        u.pm = fm + ((wgid % nig) % gsz); u.pn = (wgid % nig) / gsz; u.z = 0; u.flags = seg ? pg8::UF_EPI : pg8::UF_ZERO; u.lda = 1024; u.ldb = 2048; u.K = 1024; u.kind = 0;
        u.A = ws + (unsigned)((sg ? w2::KWT : w2::HN) + (unsigned)u.pm * 256 * 1024 * 2); u.B = ws + (b_off + ((unsigned)u.pn * 256 * 2048 + sg * 1024) * 2); return true;
    }
};
struct SchedOddIn {
    SchedGrid g;
    __device__ __forceinline__ bool at(int L, pg8::Unit& u) const {
        if (!g.at(L, u)) return false;
        if (u.pn == 5) { const char* t = u.A; u.A = u.B; u.B = t; }
        return true;
    }
};
struct EpiOddIn {
    static constexpr int NV = 0;
    static constexpr bool PERM = true;
    wsp_t ws; const float* qg; const float* kg;
    __device__ __forceinline__ void mid(pg8::f32x4 (&)[2][2][4][2], const pg8::Unit&, int, int, int, int) const {}
    __device__ __forceinline__ void operator()(const pg8::f32x4 (&acc)[2][2][4][2], const pg8::Unit& u, int wr, int wc, int fr, int fq) const {
        const int pn = u.pn;
        f32x4 rc[4];
#pragma unroll
        for (int q = 0; q < 4; ++q) rc[q] = (f32x4){0.f, 0.f, 0.f, 0.f};
        const float* gp = (pn < 4) ? qg : kg;
        if (pn < 5) {
            if (fq < 2) { const unsigned tok0 = (unsigned)u.pm * 256 + wr * 64 + fr;
#pragma unroll
                for (int q = 0; q < 4; ++q) rc[q] = *WB2(const f32x4, ws, w2::ROPE, tok0 * 64 + q * 16); } }
#pragma unroll
        for (int ai = 0; ai < 2; ++ai)
#pragma unroll
            for (int m = 0; m < 4; ++m) {
                const unsigned r = ai * 128 + wr * 64 + m * 16 + fr, tok = (unsigned)u.pm * 256 + r;
                if (pn < 5) {

                    f32x4 v[2][2]; float ss = 0.f;
#pragma unroll
                    for (int bj = 0; bj < 2; ++bj)
#pragma unroll
                        for (int n = 0; n < 2; ++n) { v[bj][n] = acc[ai][bj][m][n]; ss += (v[bj][n].x * v[bj][n].x + v[bj][n].y * v[bj][n].y) + (v[bj][n].z * v[bj][n].z + v[bj][n].w * v[bj][n].w); }
                    ss = sum_x32(sum_x16(ss));
                    const float rstd = rsqrtf(ss * (1.f / 64.f) + EPS);
#pragma unroll
                    for (int bj = 0; bj < 2; ++bj)
#pragma unroll
                        for (int n = 0; n < 2; ++n) v[bj][n] = v[bj][n] * rstd * *(const f32x4*)(gp + 32 * bj + 8 * fq + 4 * n);
                    f32x4 p0, p1;
                    const int ln_ = fq << 4; p0.x = other_x16(v[0][0].x, ln_); p0.y = other_x16(v[0][0].y, ln_); p0.z = other_x16(v[0][0].z, ln_); p0.w = other_x16(v[0][0].w, ln_);
                    p1.x = other_x16(v[0][1].x, ln_); p1.y = other_x16(v[0][1].y, ln_); p1.z = other_x16(v[0][1].z, ln_); p1.w = other_x16(v[0][1].w, ln_);
                    if (fq < 2) {
                        const f32x4 c0 = rc[0], c1 = rc[1], s0 = rc[2], s1 = rc[3];
                        const float sg = (fq == 0) ? -1.f : 1.f;
                        v[0][0] = v[0][0] * c0 + p0 * s0 * sg; v[0][1] = v[0][1] * c1 + p1 * s1 * sg;
                        if ((ai * 4 + m) < 7) { const unsigned tokn = tok + ((m == 3) ? 128u - 48u : 16u);
#pragma unroll
                            for (int q = 0; q < 4; ++q) rc[q] = *WB2(const f32x4, ws, w2::ROPE, tokn * 64 + q * 16); }
                    }
#pragma unroll
                    for (int bj = 0; bj < 2; ++bj) {
                        u32x4 w; w.x = pk2(v[bj][0].x, v[bj][0].y); w.y = pk2(v[bj][0].z, v[bj][0].w); w.z = pk2(v[bj][1].x, v[bj][1].y); w.w = pk2(v[bj][1].z, v[bj][1].w);
                        const unsigned d = 32 * bj + 8 * fq;
                        if (pn < 4) *WB2(u32x4, ws, w2::QO, (tok * 1024 + (pn * 4 + wc) * 64 + d) * 2) = w; else *WB2(u32x4, ws, w2::KO, (tok * 256 + wc * 64 + d) * 2) = w;
                    }
                } else if (pn == 5) {
#pragma unroll
                    for (int bj = 0; bj < 2; ++bj) {
                        const unsigned c = bj * 128 + wc * 32 + 8 * fq; const f32x4 lo = acc[ai][bj][m][0], hi = acc[ai][bj][m][1];
                        u32x4 w; w.x = pk2(lo.x, lo.y); w.y = pk2(lo.z, lo.w); w.z = pk2(hi.x, hi.y); w.w = pk2(hi.z, hi.w);
                        *WB2(u32x4, ws, w2::VTG, (r * MTOK + (unsigned)u.pm * 256 + c) * 2) = w;
                    }
                } else {
#pragma unroll
                    for (int bj = 0; bj < 2; ++bj) {
                        const unsigned c = (pn - 6) * 256 + bj * 128 + wc * 32 + 8 * fq; const f32x4 lo = acc[ai][bj][m][0], hi = acc[ai][bj][m][1];
                        u32x4 w; w.x = pk2(silu_f(lo.x), silu_f(lo.y)); w.y = pk2(silu_f(lo.z), silu_f(lo.w)); w.z = pk2(silu_f(hi.x), silu_f(hi.y)); w.w = pk2(silu_f(hi.z), silu_f(hi.w));
                        *WB2(u32x4, ws, w2::ZO, (tok * 1024 + c) * 2) = w;
                    }
                }
            }
    }
};
#define LAS __attribute__((address_space(3)))
#define XB_TMO      128
#define XB_XCNT(j)  (256  + 64 * (j))
#define XB_XSUB(j)  (1280 + 64 * (j))
#define XB_XGEN(j)  (2304 + 64 * (j))
#define XB_TOP      3328
#define XB_TOPGEN   3392
#define XCD_BAR_WORDS 3456
#define XB_SPIN_CAP (1u << 22)
__device__ __forceinline__ unsigned xb_ld(unsigned* p)              { return __hip_atomic_load(p, __ATOMIC_RELAXED, __HIP_MEMORY_SCOPE_AGENT); }
__device__ __forceinline__ unsigned xb_add(unsigned* p, unsigned v) { return __hip_atomic_fetch_add(p, v, __ATOMIC_RELAXED, __HIP_MEMORY_SCOPE_AGENT); }
__device__ __forceinline__ unsigned xb_xcc_id() { return (unsigned)__builtin_amdgcn_s_getreg((3 << 11) | 20) & 0xFu; }
#define XB_SPIN(cond, bar) do { unsigned _sp = 0; while (cond) { __builtin_amdgcn_s_sleep(1); \
    if ((++_sp & 255u) == 0u) { if (xb_ld(&(bar)[XB_TMO])) break; if (_sp > XB_SPIN_CAP) { atomicAdd(&(bar)[XB_TMO], 1u); break; } } } } while (0)
struct XcdBarrier { unsigned* bar; unsigned x; volatile LAS unsigned* st; };
__device__ __forceinline__ XcdBarrier xcd_barrier_post(unsigned* bar, volatile LAS unsigned* st, int wv0) {
    XcdBarrier b; b.bar = bar; b.x = xb_xcc_id(); b.st = st;
    if (tidx(wv0) == 0) st[3] = xb_add(&bar[XB_XCNT(b.x)], 1u);
    return b;
}
__device__ __forceinline__ void xcd_barrier_complete(unsigned* bar, unsigned x, unsigned& nloc, unsigned& nx, unsigned& uni) {
    const unsigned G = gridDim.x * gridDim.y * gridDim.z;
    unsigned sum, cnt, bad, sp = 0u;
    for (;;) {
        sum = 0u; cnt = 0u; bad = 0u;
#pragma unroll 1
        for (unsigned j = 0; j < 16; ++j) { const unsigned c = xb_ld(&bar[XB_XCNT(j)]); sum += c; cnt += (c > 0u) ? 1u : 0u; bad |= (c != (j < 8u ? 32u : 0u)) ? 1u : 0u; }
        if (sum == G) break;
        __builtin_amdgcn_s_sleep(1);
        if ((++sp & 255u) == 0u) { if (xb_ld(&bar[XB_TMO])) break; if (sp > XB_SPIN_CAP) { atomicAdd(&bar[XB_TMO], 1u); break; } }
    }
    const unsigned mine = xb_ld(&bar[XB_XCNT(x)]);
    nloc = mine > 0u ? mine : 1u; nx = cnt > 0u ? cnt : 1u;
    uni = (bad == 0u && sum == 256u && G == 256u) ? 1u : 0u;
}
__device__ __forceinline__ void xcd_barrier(const XcdBarrier& b, int wv0) {
    asm volatile("s_waitcnt vmcnt(0)" ::: "memory");
    __syncthreads();
    if (tidx(wv0) == 0) {
        unsigned* bar = b.bar;
        __builtin_amdgcn_s_waitcnt(0);
        unsigned nloc = b.st[0], nx = b.st[1];
        if (nloc == 0u) { unsigned uni; xcd_barrier_complete(bar, b.x, nloc, nx, uni); b.st[0] = nloc; b.st[1] = nx; b.st[2] = uni; }
        const unsigned old = xb_add(&bar[XB_XSUB(b.x)], 1u);
        const unsigned gen = old / nloc;
        if (old + 1u == (gen + 1u) * nloc) {
            __builtin_amdgcn_fence(__ATOMIC_RELEASE, "agent");
            asm volatile("s_waitcnt vmcnt(0)" ::: "memory");
            const unsigned og = xb_add(&bar[XB_TOP], 1u);
            const unsigned tg = og / nx;
            if (og + 1u == (tg + 1u) * nx) xb_add(&bar[XB_TOPGEN], 1u);
            else XB_SPIN(xb_ld(&bar[XB_TOPGEN]) == tg, bar);
            __builtin_amdgcn_fence(__ATOMIC_ACQUIRE, "agent");
            asm volatile("s_waitcnt vmcnt(0)" ::: "memory");
        } else {
            XB_SPIN(xb_ld(&bar[XB_TOPGEN]) == gen, bar);
            __builtin_amdgcn_fence(__ATOMIC_ACQUIRE, "agent");
            asm volatile("s_waitcnt vmcnt(0)" ::: "memory");
        }
    }
    __syncthreads();
}
__device__ __forceinline__ void xcd_local_barrier(const XcdBarrier& b, int wv0) {
    asm volatile("s_waitcnt vmcnt(0)" ::: "memory");
    __syncthreads();
    if (tidx(wv0) == 0) {
        unsigned* bar = b.bar;
        __builtin_amdgcn_s_waitcnt(0);
        const unsigned old = xb_add(&bar[XB_XGEN(b.x)], 1u);
        const unsigned tgt = (old / 32u + 1u) * 32u;
        XB_SPIN(xb_ld(&bar[XB_XGEN(b.x)]) < tgt, bar);
        asm volatile("buffer_inv sc0\n\ts_waitcnt vmcnt(0)" ::: "memory");
    }
    __syncthreads();
}

__device__ __forceinline__ void adaln_item(float* sm, int item, const float* __restrict__ c, const float* __restrict__ ada_w, const float* __restrict__ ada_b, float* __restrict__ mod, int wv0) {
    int tid_ = tidx(wv0); asm volatile("" : "+v"(tid_)); const int tid = tid_, lane = tid & 63, wv = tid >> 6, l = item / 48, cg = item % 48;
    float* part = sm + 16384;
    for (int i = tid; i < 16384; i += 512) { const float v = c[i]; sm[i] = v / (1.f + expf(-v)); }
    __syncthreads();
    float acc[16];
#pragma unroll
    for (int b = 0; b < 16; ++b) acc[b] = 0.f;
    const float* w = ada_w + ((size_t)l * 1024 + wv * 128) * 3072 + cg * 64 + lane;
#pragma unroll 16
    for (int k = 0; k < 128; ++k) { const float wvv = w[(size_t)k * 3072];
#pragma unroll
        for (int b = 0; b < 16; ++b) acc[b] += sm[b * 1024 + wv * 128 + k] * wvv; }
#pragma unroll
    for (int b = 0; b < 16; ++b) part[(wv * 16 + b) * 64 + lane] = acc[b];
    __syncthreads();
    for (int o = tid; o < 1024; o += 512) { const int b = o >> 6, ln = o & 63; float s = 0.f;
#pragma unroll
        for (int w8 = 0; w8 < 8; ++w8) s += part[(w8 * 16 + b) * 64 + ln];
        mod[(size_t)(l * 16 + b) * 3072 + cg * 64 + ln] = s + ada_b[l * 3072 + cg * 64 + ln]; }
    __syncthreads();
}
__device__ __forceinline__ void wt_tile(float* t  , const float* __restrict__ W, int K, int N, bf16* __restrict__ WT, int tile, float scale, bool perm, int wv0) {
    int tid_ = tidx(wv0); asm volatile("" : "+v"(tid_)); const int tiles_n = N / 64, tk = tile / tiles_n, tn = tile % tiles_n, tid = tid_;
#pragma unroll
    for (int r = 0; r < 8; ++r) { const int i = tid + 512 * r, kk = i >> 6, nn = i & 63; const int ncol = perm ? oddin_logical_col(tn * 64 + nn) : tn * 64 + nn;
        t[kk * 65 + nn] = W[(size_t)(tk * 64 + kk) * N + ncol]; }
    __syncthreads();
#pragma unroll
    for (int r = 0; r < 8; ++r) { const int i = tid + 512 * r, nn = i >> 6, kk = i & 63; WT[(size_t)(tn * 64 + nn) * K + tk * 64 + kk] = f2bf(t[kk * 65 + nn] * scale); }
    __syncthreads();
}
__device__ __forceinline__ float ssq8(u32x4 w) {
    const float a = bflo(w.x), b = bfhi(w.x), c = bflo(w.y), d = bfhi(w.y), e = bflo(w.z), f = bfhi(w.z), g = bflo(w.w), h = bfhi(w.w);
    return ((a * a + b * b) + (c * c + d * d)) + ((e * e + f * f) + (g * g + h * h));
}
__device__ __forceinline__ u32x4 norm8v(u32x4 w, float r, const float* gs, const float* sf) {
    u32x4 o;
    o.x = pk2(bflo(w.x) * r * gs[0] + sf[0], bfhi(w.x) * r * gs[1] + sf[1]); o.y = pk2(bflo(w.y) * r * gs[2] + sf[2], bfhi(w.y) * r * gs[3] + sf[3]);
    o.z = pk2(bflo(w.z) * r * gs[4] + sf[4], bfhi(w.z) * r * gs[5] + sf[5]); o.w = pk2(bflo(w.w) * r * gs[6] + sf[6], bfhi(w.w) * r * gs[7] + sf[7]);
    return o;
}
__device__ __forceinline__ void norm_rows_b(int gwave, int nwaves, int lane, const bf16* __restrict__ h, const float* __restrict__ g, const float* __restrict__ modl, bf16* __restrict__ hn, int row0, int nrows) {
    asm volatile("" : "+v"(lane));
    const int R = (nrows + nwaves - 1) / nwaves, ra0 = gwave * R, ra1 = min(ra0 + R, nrows);
    if (ra0 >= ra1) return;
    float gs[16], sf[16]; int cb = -1;
    u32x4 cur[4][2], nxt[4][2];
#pragma unroll
    for (int q = 0; q < 4; ++q) { const u32x4* x = (const u32x4*)(h + (size_t)(row0 + min(ra0 + q, ra1 - 1)) * DM) + lane; cur[q][0] = x[0]; cur[q][1] = x[64]; }
    for (int rl = ra0; rl < ra1; rl += 4) {
        auto load_mod = [&](int b) { cb = b; const float* sh = modl + (size_t)b * 3072;
#pragma unroll
            for (int q = 0; q < 2; ++q) { const int col = q * 512 + lane * 8;
                const f32x4 g0 = *(const f32x4*)(g + col), g1 = *(const f32x4*)(g + col + 4), c0 = *(const f32x4*)(sh + 1024 + col) + 1.0f, c1 = *(const f32x4*)(sh + 1028 + col) + 1.0f, s0 = *(const f32x4*)(sh + col), s1 = *(const f32x4*)(sh + col + 4);
                gs[q * 8 + 0] = g0.x * c0.x; gs[q * 8 + 1] = g0.y * c0.y; gs[q * 8 + 2] = g0.z * c0.z; gs[q * 8 + 3] = g0.w * c0.w; gs[q * 8 + 4] = g1.x * c1.x; gs[q * 8 + 5] = g1.y * c1.y; gs[q * 8 + 6] = g1.z * c1.z; gs[q * 8 + 7] = g1.w * c1.w;
                sf[q * 8 + 0] = s0.x; sf[q * 8 + 1] = s0.y; sf[q * 8 + 2] = s0.z; sf[q * 8 + 3] = s0.w; sf[q * 8 + 4] = s1.x; sf[q * 8 + 5] = s1.y; sf[q * 8 + 6] = s1.z; sf[q * 8 + 7] = s1.w; } };
        {
#pragma unroll
            for (int q = 0; q < 4; ++q) { const u32x4* x = (const u32x4*)(h + (size_t)(row0 + min(rl + 4 + q, ra1 - 1)) * DM) + lane; nxt[q][0] = x[0]; nxt[q][1] = x[64]; }
        }
#pragma unroll
        for (int q = 0; q < 4; ++q) {
            const float r = rsqrtf(wave_sum(ssq8(cur[q][0]) + ssq8(cur[q][1])) * (1.f / DM) + EPS);
            if (rl + q < ra1) { const int bq = (row0 + rl + q) >> 12; if (bq != cb) load_mod(bq);
                u32x4* o = (u32x4*)(hn + (size_t)(rl + q) * DM) + lane; o[0] = norm8v(cur[q][0], r, gs, sf); o[64] = norm8v(cur[q][1], r, gs + 8, sf + 8); }
        }
#pragma unroll
        for (int q = 0; q < 4; ++q) { cur[q][0] = nxt[q][0]; cur[q][1] = nxt[q][1]; }
    }
}
__device__ __forceinline__ void norm_rows(int gwave, int nwaves, int lane, const float* __restrict__ h, const float* __restrict__ g, const float* __restrict__ modl, bf16* __restrict__ hn, bf16* __restrict__ hb, int row0, int nrows) {
    asm volatile("" : "+v"(lane));
    const int R = (nrows + nwaves - 1) / nwaves, ra0 = gwave * R, ra1 = min(ra0 + R, nrows);
    if (ra0 >= ra1) return;
    f32x4 gs[4], sf[4]; int cb = -1;
    f32x4 cur[2][4], nxt[2][4];
#pragma unroll
    for (int q = 0; q < 2; ++q) { const f32x4* x = (const f32x4*)(h + (size_t)(row0 + min(ra0 + q, ra1 - 1)) * DM) + lane;
#pragma unroll
        for (int j = 0; j < 4; ++j) cur[q][j] = x[64 * j]; }
    for (int rl = ra0; rl < ra1; rl += 2) {
        auto load_mod = [&](int b) { cb = b; const float* sh = modl + (size_t)b * 3072;
#pragma unroll
            for (int j = 0; j < 4; ++j) { const int col = (lane + 64 * j) * 4; gs[j] = *(const f32x4*)(g + col) * (*(const f32x4*)(sh + 1024 + col) + 1.0f); sf[j] = *(const f32x4*)(sh + col); } };
        {
#pragma unroll
            for (int q = 0; q < 2; ++q) { const f32x4* x = (const f32x4*)(h + (size_t)(row0 + min(rl + 2 + q, ra1 - 1)) * DM) + lane;
#pragma unroll
                for (int j = 0; j < 4; ++j) nxt[q][j] = x[64 * j]; }
        }
#pragma unroll
        for (int q = 0; q < 2; ++q) {
            float ss = 0.f;
#pragma unroll
            for (int j = 0; j < 4; ++j) ss += (cur[q][j].x * cur[q][j].x + cur[q][j].y * cur[q][j].y) + (cur[q][j].z * cur[q][j].z + cur[q][j].w * cur[q][j].w);
            const float r = rsqrtf(wave_sum(ss) * (1.f / DM) + EPS);
            if (rl + q < ra1) { const int bq = (row0 + rl + q) >> 12; if (bq != cb) load_mod(bq);
                u32x2* o = (u32x2*)(hn + (size_t)(rl + q) * DM) + lane; u32x2* c = (u32x2*)(hb + (size_t)(row0 + rl + q) * DM) + lane;
#pragma unroll
                for (int j = 0; j < 4; ++j) { const f32x4 y = cur[q][j] * r * gs[j] + sf[j]; u32x2 w; w.x = pk2(y.x, y.y); w.y = pk2(y.z, y.w); o[64 * j] = w;
                    u32x2 cw; cw.x = pk2(cur[q][j].x, cur[q][j].y); cw.y = pk2(cur[q][j].z, cur[q][j].w); c[64 * j] = cw; }
            }
        }
#pragma unroll
        for (int q = 0; q < 2; ++q)
#pragma unroll
            for (int j = 0; j < 4; ++j) cur[q][j] = nxt[q][j];
    }
}

constexpr int MEGA_LDS = 147456, LDS_XS = 131072, LDS_QN = LDS_XS + 4096, LDS_MISC = MEGA_LDS - 128;
constexpr int CW_BAR = 4096;
constexpr size_t CTL_ZERO_BYTES = 64 * 1024;
struct MArgs { const float* in[32]; float* out; unsigned char* ws; int seq_lo, seq_hi; };
#define KIN(i) (kp->in[i])
#define WSP(T, off) ((T*)(kp->ws + (off)))
__global__ void __launch_bounds__(512, 2) mega(MArgs a_unused) {
    extern __shared__ __attribute__((aligned(16))) unsigned char lds[];
    typedef const MArgs __attribute__((address_space(4))) KA;
    volatile LAS unsigned* MISC = (volatile LAS unsigned*)((LAS unsigned char*)lds + LDS_MISC);
    const int wv0 = __builtin_amdgcn_readfirstlane((int)threadIdx.x >> 6);
    if (tidx(wv0) < 32) MISC[tidx(wv0)] = 0u;
    __syncthreads();
    int seq_lo, seq_hi;
    XcdBarrier bar;
    { KA* kp = (KA*)__builtin_amdgcn_kernarg_segment_ptr(); seq_lo = kp->seq_lo; seq_hi = kp->seq_hi; bar = xcd_barrier_post((unsigned*)(kp->ws + w2::CTL) + CW_BAR, MISC + 8, wv0); }
    PG8_LAS unsigned char* glds = (PG8_LAS unsigned char*)lds;
    int seq = 0;
#define PH_BEGIN if (seq >= seq_lo && seq < seq_hi) { {
#define CTX KA* kp = (KA*)__builtin_amdgcn_kernarg_segment_ptr(); int G = gridDim.x, cwg = blockIdx.x, tid = tidx(wv0); \
        asm volatile("" : "+s"(kp)); asm volatile("" : "+s"(G)); asm volatile("" : "+s"(cwg)); asm volatile("" : "+v"(tid)); const int lane = tid & 63, wv = __builtin_amdgcn_readfirstlane(tid >> 6); (void)lane; (void)wv;
#define SUB } { CTX
#define PH_END   } if (seq + 1 < seq_hi) xcd_barrier(bar, wv0); } ++seq;
#define GTID (cwg * 512 + tid)
#define ISLIDS const int isl_ = __builtin_amdgcn_readfirstlane((int)MISC[10]), rk_ = __builtin_amdgcn_readfirstlane((int)MISC[11]); \
        const int vcw = isl_ ? rk_ * 8 + (int)bar.x : cwg, bcw = isl_ ? (int)bar.x * 32 + rk_ : cwg; (void)vcw; (void)bcw;
#define PH_END_ISL } if (seq + 1 < seq_hi) { if (__builtin_amdgcn_readfirstlane((int)MISC[10])) xcd_local_barrier(bar, wv0); else xcd_barrier(bar, wv0); } } ++seq;
#define NTHR (G * 512)

    PH_BEGIN CTX
        for (int it = (G == 256 ? cwg - 64 : cwg); it < 192; it += G) if (it >= 0) adaln_item((float*)lds, it, KIN(1), KIN(3), KIN(4), WSP(float, w2::MOD), wv0);
        SUB
        for (int eg = cwg; eg < 128; eg += G) s5_build_mats(lds, eg, KIN(7), KIN(8), KIN(9), KIN(10), KIN(11), KIN(12), KIN(13), KIN(14), WSP(bf16, w2::KC), WSP(bf16, w2::BMAT), WSP(float, w2::AT16), wv0);
        SUB
        {
            constexpr int T0 = 2048, T1 = T0 + 512, T2 = T1 + 128, T3 = T2 + 128, T4 = T3 + 128, T5 = T4 + 128, T6 = T5 + 1024, T7 = T6 + 1280, T8 = T7 + 512;
            float* tl = (float*)lds;
            static_assert(T8 == 64 * 31 + 64 * 11 + 128 * 25, "tile deal");
            int t_start = cwg, t_stride = G, t_cnt = (T8 - cwg + G - 1) / G;
            if (G == 256) { t_stride = 1; if (cwg < 64) { t_start = cwg * 31; t_cnt = 31; } else if (cwg < 128) { t_start = 64 * 31 + (cwg - 64) * 11; t_cnt = 11; } else { t_start = 64 * 31 + 64 * 11 + (cwg - 128) * 25; t_cnt = 25; } }
            for (int tj = 0; tj < t_cnt; ++tj) { const int it = t_start + tj * t_stride;
                if (it < T0) { const int z = it / 1024, t = it % 1024; wt_tile(tl, KIN(6) + (size_t)z * 1024 * 4096, 1024, 4096, WSP(bf16, w2::W_EIN) + (size_t)z * 1024 * 4096, t, 1.f, false, wv0); }
                else if (it < T1) { const int r = it - T0, z = r / 256, t = r % 256; wt_tile(tl, KIN(15) + (size_t)z * 1024 * 1024, 1024, 1024, WSP(bf16, w2::W_GLU) + (size_t)z * 1024 * 1024, t, 1.f, false, wv0); }
                else if (it < T3) { }
                else if (it < T4) { const int r = it - T3, z = r / 16, t = r % 16; wt_tile(tl, KIN(20) + (size_t)z * 65536, 256, 256, WSP(bf16, w2::W_V) + (size_t)z * 65536, t, 1.f, false, wv0); }
                else if (it < T5) { const int r = it - T4, z = r / 16, t = r % 16; wt_tile(tl, KIN(21) + (size_t)z * 65536, 256, 256, WSP(bf16, w2::W_O) + (size_t)z * 65536, t, 1.f, false, wv0); }
                else if (it < T6) { const int r = it - T5, z = r / 512, t = r % 512; wt_tile(tl, KIN(26) + (size_t)z * 2048 * 1024, 2048, 1024, WSP(bf16, w2::W_EOUT) + (size_t)z * 2048 * 1024, t, 1.f, false, wv0); }
                else if (it < T7) { const int r = it - T6, z = r / 640, t = r % 640; wt_tile(tl, KIN(27) + (size_t)z * 1024 * 2560, 1024, 2560, WSP(bf16, w2::W_OIN) + (size_t)z * 1024 * 2560, t, 1.f, true, wv0); }
                else { const int r = it - T7, z = r / 256, t = r % 256; wt_tile(tl, KIN(31) + (size_t)z * 1024 * 1024, 1024, 1024, WSP(bf16, w2::W_OOUT) + (size_t)z * 1024 * 1024, t, 1.f, false, wv0); }
            }
        }
        SUB
        for (int it = (G == 256 ? cwg - 128 : cwg); it < 8 * 16; it += G) if (it >= 0) {
            const int z = it >> 4, n0 = ((it >> 2) & 3) * 64, k0 = (it & 3) * 64;
            float* sq = (float*)lds; float* sk = sq + 64 * 257;
            for (int i = tid; i < 64 * 64; i += 512) { const int r = i >> 6, c4 = (i & 63) * 4;
                const f32x4 a = *(const f32x4*)(KIN(18) + (size_t)z * 65536 + (size_t)(k0 + r) * 256 + c4), b = *(const f32x4*)(KIN(19) + (size_t)z * 65536 + (size_t)(n0 + r) * 256 + c4);
                sq[r * 257 + c4] = a.x; sq[r * 257 + c4 + 1] = a.y; sq[r * 257 + c4 + 2] = a.z; sq[r * 257 + c4 + 3] = a.w; sk[r * 257 + c4] = b.x; sk[r * 257 + c4 + 1] = b.y; sk[r * 257 + c4 + 2] = b.z; sk[r * 257 + c4 + 3] = b.w; }
            __syncthreads();
            { const int kk = tid & 63, nb = (tid >> 6) * 8; float s[8];
#pragma unroll
              for (int a = 0; a < 8; ++a) s[a] = 0.f;
              for (int e1 = 0; e1 < 256; ++e1) { const float qv = sq[kk * 257 + e1];
#pragma unroll
                  for (int a = 0; a < 8; ++a) s[a] += sk[(nb + a) * 257 + e1] * qv; }
#pragma unroll
              for (int a = 0; a < 8; ++a) { const size_t o = (size_t)z * 65536 + (size_t)(n0 + nb + a) * 256 + k0 + kk;
                  WSP(bf16, w2::W_Q)[o] = f2bf(s[a] * 0.0625f); WSP(bf16, w2::W_K)[o] = (n0 + nb + a == k0 + kk) ? (bf16)0x3F80 : (bf16)0; } }
            __syncthreads();
        }
        for (int i = GTID; i < 2 * 16 * 2048; i += NTHR) { const int e2 = i >> 15, n = (i >> 11) & 15, k = i & 2047; WSP(bf16, w2::WIFT)[i] = (n < 8) ? f2bf(KIN(22)[((size_t)e2 * 2048 + k) * 8 + n]) : (bf16)0; }
        rope_table_items(GTID, NTHR, (const int*)KIN(2), WSP(float, w2::ROPE));
    PH_END

    for (int layer = 0; layer < DEPTH; ++layer) {
        if ((layer & 1) == 0) {
            const int e = layer >> 1;
            for (int half = 0; half < 2; ++half) {
                PH_BEGIN CTX ISLIDS
                    if (layer == 0) norm_rows(bcw * 8 + wv, G * 8, lane, KIN(0), KIN(5) + layer * 1024, WSP(float, w2::MOD) + (size_t)layer * 16 * 3072, WSP(bf16, w2::HN), (bf16*)kp->out, half * MH, MH);
                    else norm_rows_b(bcw * 8 + wv, G * 8, lane, (const bf16*)kp->out, KIN(5) + layer * 1024, WSP(float, w2::MOD) + (size_t)layer * 16 * 3072, WSP(bf16, w2::HN), half * MH, MH);
                PH_END_ISL
                PH_BEGIN CTX ISLIDS
                    pg8::Strided<SchedEvenIn> S; S.s0.g.ws = (const char*)kp->ws; S.s0.g.a_off = w2::HN; S.s0.g.b_off = w2::W_EIN + e * (4096u * 1024 * 2); S.s0.g.a_pm = 256u * 1024 * 2; S.s0.g.b_pn = 256u * 1024 * 2;
                    S.s0.g.nM = NTILE; S.s0.g.nN = 16; S.s0.g.lda = 1024; S.s0.g.ldb = 1024; S.s0.g.K = 1024; S.s0.g.pad = 0; S.G = G; S.c = vcw;
                    pg8::Epi8<FEvenIn2> E; E.f.ws = kp->ws;
                    pg8::gemm_phase(glds, S, E, wv0);
                PH_END_ISL
                PH_BEGIN CTX ISLIDS
                    mlstm_gates_stage(lds, KIN(16) + e * 4096, KIN(17) + e * 1024, WSP(bf16, w2::WIFT) + (size_t)e * 16 * 2048, wv0);
                    for (int un = bcw; un < MH / 128; un += G) mlstm_gates_unit(lds, un, WSP(bf16, w2::MIN), KIN(23) + e * 8, WSP(bf16, w2::XC), WSP(float, w2::LI), WSP(float, w2::LF), wv0);
                    __syncthreads();
                    SUB ISLIDS
                    pg8::Strided<SchedS5> S; S.s0.ws = (const char*)kp->ws; S.s0.b_off = w2::BMAT + e * (64u * 65536 * 2); S.s0.b_g = 65536u * 2; S.s0.ldb = 256; S.s0.K = 256; S.G = G; S.c = vcw;
                    pg8::Epi8<FS5Z> E; E.f.ws = kp->ws;
                    pg8::gemm_phase(glds, S, E, wv0);
                    SUB ISLIDS
                    s5_scan_items((float*)lds, vcw, G, tid, WSP(float, w2::AT16) + (size_t)e * 64 * 128, WSP(bf16, w2::ZINC), WSP(bf16, w2::AU));
                    SUB ISLIDS
                    { pg8::Strided<SchedS5> S; S.s0.ws = (const char*)kp->ws; S.s0.b_off = w2::KC + e * (64u * 256 * AUP * 2); S.s0.b_g = 256u * AUP * 2; S.s0.ldb = AUP; S.s0.K = AUP; S.G = G; S.c = vcw;
                      EpiS5Y E; E.ws = kp->ws;
                      pg8::gemm_phase(glds, S, E, wv0); }
                PH_END_ISL
                PH_BEGIN CTX ISLIDS
                    for (int i = 0; i * G + vcw < 2 * NUNIT; ++i) { const int L = SchedProj::kv_index(i * G + vcw, G == 256);
                        if ((L & 7) < 4 && wv == (i & 7)) mlstm_chunk_scalars(lane, L >> 3, L & 3, WSP(float, w2::LI), WSP(float, w2::LF), WSP(float, w2::BCUM), WSP(float, w2::KAP), WSP(float, w2::PMX), WSP(float, w2::WEXP), WSP(float, w2::BT), WSP(float, w2::MLOC)); }
                    asm volatile("s_waitcnt vmcnt(0)" ::: "memory"); __syncthreads();
                    SUB ISLIDS
                    SchedProj S; S.pair = (G == 256); S.G = G; S.c = vcw;
                    S.s1.ws = (const char*)kp->ws; S.s1.w_off = w2::W_K + e * (4u * 65536 * 2);
                    EpiKV E; E.ws = kp->ws;
                    pg8::gemm_phase(glds, S, E, wv0);
                    SUB ISLIDS
                    if (G == 256) { pg8::Strided<SchedDC> S; S.s0.ws = (const char*)kp->ws; S.G = G; S.c = vcw;
                      pg8::Epi8<FDC> E; E.f.ws = kp->ws;
                      pg8::gemm_phase(glds, S, E, wv0); }
                PH_END_ISL
                if (gridDim.x != 256) {
                PH_BEGIN CTX
                    pg8::Strided<SchedDC> S; S.s0.ws = (const char*)kp->ws; S.G = G; S.c = cwg;
                    pg8::Epi8<FDC> E; E.f.ws = kp->ws;
                    pg8::gemm_phase(glds, S, E, wv0);
                PH_END
                }
                PH_BEGIN CTX ISLIDS
                    if (isl_) { const int i0 = ((int)bar.x << 15) + rk_ * 1024 + tid; mlstm_scan_items(i0, 512, i0 + 1024, bcw, G, tid, WSP(bf16, w2::CT), WSP(float, w2::BT), WSP(float, w2::MLOC), WSP(float, w2::DNP), WSP(float, w2::NST)); }
                    else mlstm_scan_items(GTID, NTHR, 32 * 256 * 32, cwg, G, tid, WSP(bf16, w2::CT), WSP(float, w2::BT), WSP(float, w2::MLOC), WSP(float, w2::DNP), WSP(float, w2::NST));
                    SUB ISLIDS
                    { pg8::Strided<SchedGrid> S; S.s0.ws = (const char*)kp->ws; S.s0.a_off = w2::Z; S.s0.b_off = w2::W_GLU + e * (1024u * 1024 * 2); S.s0.a_pm = 256u * 1024 * 2; S.s0.b_pn = 256u * 1024 * 2;
                      S.s0.nM = NTILE; S.s0.nN = 4; S.s0.lda = 1024; S.s0.ldb = 1024; S.s0.K = 1024; S.G = G; S.c = vcw;
                      EpiGlu E; E.ws = kp->ws;
                      pg8::gemm_phase(glds, S, E, wv0); }
                PH_END_ISL
                PH_BEGIN CTX ISLIDS
                    { SchedQO S; S.G = G; S.c = vcw; S.s0.ws = (const char*)kp->ws; S.s0.w_off = w2::W_Q + e * (4u * 65536 * 2);
                      EpiXO E; E.base.f.ws = kp->ws; E.qnp = (PG8_LAS float*)(glds + LDS_QN);
                      pg8::gemm_phase(glds, S, E, wv0); }
                    SUB ISLIDS
                    { pg8::Strided<SchedS> S; S.s0.ws = (const char*)kp->ws; S.G = G; S.c = vcw;
                      EpiS E; E.ws = kp->ws;
                      pg8::gemm_phase(glds, S, E, wv0); }
                    SUB ISLIDS
                    SchedQP S; S.ws = (const char*)kp->ws; S.G = G; S.c = vcw;
                    EpiQP E; E.ws = kp->ws; E.ng = KIN(24) + e * 1024; E.skip = KIN(25) + e * 1024; E.qn = (PG8_LAS float*)(glds + LDS_QN); E.xs = (PG8_LAS float*)(glds + LDS_XS);
                    pg8::gemm_phase(glds, S, E, wv0);
                PH_END_ISL
                PH_BEGIN CTX ISLIDS
                    SchedOut2 S; S.ws = (const char*)kp->ws; S.b_off = w2::W_EOUT + e * (1024u * 2048 * 2); S.G = G; S.c = vcw;
                    EpiResidH E; E.hsrc = (const bf16*)kp->out; E.dst = kp->out; if (layer == DEPTH - 2) E.dst = WSP(bf16, w2::HC); E.dst_f32 = 0; E.ws = kp->ws; E.goff = w2::MOD + (layer * 16 * 3072 + 2048) * 4; E.row0 = half * MH;
                    pg8::gemm_phase(glds, S, E, wv0);
                } if (seq + 1 < seq_hi) { if (half == 0 && __builtin_amdgcn_readfirstlane((int)MISC[10])) xcd_local_barrier(bar, wv0); else xcd_barrier(bar, wv0); } } ++seq;
            }
        } else {
            const int o = layer >> 1;
            PH_BEGIN CTX ISLIDS
                const bf16* hsrc = (const bf16*)kp->out; if (layer == DEPTH - 1) hsrc = WSP(bf16, w2::HC);
                norm_rows_b(bcw * 8 + wv, G * 8, lane, hsrc, KIN(5) + layer * 1024, WSP(float, w2::MOD) + (size_t)layer * 16 * 3072, WSP(bf16, w2::HN), 0, MTOK);
            PH_END_ISL
            PH_BEGIN CTX ISLIDS
                pg8::Strided<SchedOddIn> S; S.s0.g.ws = (const char*)kp->ws; S.s0.g.a_off = w2::HN; S.s0.g.b_off = w2::W_OIN + o * (2560u * 1024 * 2); S.s0.g.a_pm = 256u * 1024 * 2; S.s0.g.b_pn = 256u * 1024 * 2;
                S.s0.g.nM = MTOK / 256; S.s0.g.nN = 10; S.s0.g.lda = 1024; S.s0.g.ldb = 1024; S.s0.g.K = 1024; S.G = G; S.c = vcw;
                EpiOddIn E; E.ws = kp->ws; E.qg = KIN(28) + o * 64; E.kg = KIN(29) + o * 64;
                pg8::gemm_phase(glds, S, E, wv0);
            PH_END_ISL
            PH_BEGIN CTX ISLIDS
                attn_phase(lds, G, vcw, WSP(bf16, w2::QO), WSP(bf16, w2::KO), WSP(bf16, w2::VTG), WSP(bf16, w2::ZO), KIN(30) + o * 16, WSP(bf16, w2::ABUF), wv0);
            PH_END_ISL
            PH_BEGIN CTX ISLIDS
                pg8::Strided<SchedGrid> S; S.s0.ws = (const char*)kp->ws; S.s0.a_off = w2::ABUF; S.s0.b_off = w2::W_OOUT + o * (1024u * 1024 * 2); S.s0.a_pm = 256u * 1024 * 2; S.s0.b_pn = 256u * 1024 * 2;
                S.s0.nM = MTOK / 256; S.s0.nN = 4; S.s0.lda = 1024; S.s0.ldb = 1024; S.s0.K = 1024; S.G = G; S.c = vcw;
                EpiResidH E; E.dst_f32 = layer == DEPTH - 1; E.hsrc = (const bf16*)kp->out; if (E.dst_f32) E.hsrc = WSP(bf16, w2::HC); E.dst = kp->out; E.ws = kp->ws; E.goff = w2::MOD + (layer * 16 * 3072 + 2048) * 4; E.row0 = 0;
                pg8::gemm_phase(glds, S, E, wv0);
            PH_END
        }
    }
#undef PH_BEGIN
#undef PH_END
}
constexpr int N_SEQ_MAX = 1 + 2 * 16 + 2 * 4;
__host__ __device__ constexpr int n_seq(int grid) { return grid == 256 ? N_SEQ_MAX - 4 : N_SEQ_MAX; }

#ifndef MEGA_MULTI
#define MEGA_MULTI 0
#endif
extern "C" void kernel_launch(void* const* d_in, const int* in_sizes, int n_in, void* d_out, int out_size, void* d_ws, size_t ws_size, hipStream_t stream) {
    static int grid = 0;
    if (grid == 0) {
        if (n_in != 32 || out_size != MTOK * DM || ws_size < w2::END) { fprintf(stderr, "kernel_launch: unexpected shapes (n_in %d, out %d, ws %zu)\n", n_in, out_size, ws_size); grid = -1; return; }
        int dev = 0, cus = 0, per_cu = 0;
        if (hipGetDevice(&dev) != hipSuccess || hipDeviceGetAttribute(&cus, hipDeviceAttributeMultiprocessorCount, dev) != hipSuccess) { grid = -1; return; }
        if (hipFuncSetAttribute((const void*)mega, hipFuncAttributeMaxDynamicSharedMemorySize, MEGA_LDS) != hipSuccess) { fprintf(stderr, "kernel_launch: hipFuncSetAttribute failed\n"); grid = -1; return; }
        if (hipOccupancyMaxActiveBlocksPerMultiprocessor(&per_cu, (const void*)mega, 512, MEGA_LDS) != hipSuccess || per_cu < 1) { fprintf(stderr, "kernel_launch: occupancy query says %d\n", per_cu); }
        (void)hipGetLastError();
        grid = cus;
        if (grid < 128) { fprintf(stderr, "kernel_launch: needs >= 128 CUs\n"); grid = -1; return; }
    }
    if (grid < 0) return;
    (void)hipMemsetAsync((char*)d_ws + w2::CTL, 0, CTL_ZERO_BYTES, stream);
    MArgs a; memset(&a, 0, sizeof a);
    for (int i = 0; i < 32; ++i) a.in[i] = (const float*)d_in[i];
    a.out = (float*)d_out; a.ws = (unsigned char*)d_ws;
#if MEGA_MULTI
    for (int s = 0; s < n_seq(grid); ++s) { a.seq_lo = s; a.seq_hi = s + 1; hipLaunchKernelGGL(mega, dim3(grid), dim3(512), MEGA_LDS, stream, a); }
#else
    a.seq_lo = 0; a.seq_hi = n_seq(grid);
    hipLaunchKernelGGL(mega, dim3(grid), dim3(512), MEGA_LDS, stream, a);
#endif
}
```
